# Optimizing an MI355X kernel written in HIP

```python
import math
import jax, jax.numpy as jnp
from jax import lax
import numpy as np

D_MODEL = 2048
BATCH = 4
SEQ = 2048
DEPTH = 1

HEAD_DIM = 128
N_HEADS = D_MODEL // HEAD_DIM
N_KV_HEADS = 4
ROPE_DIM = HEAD_DIM // 4
ROPE_THETA = 500000.0
N_IDX_HEADS = 16
IDX_DIM = 64
IDX_ROPE_DIM = IDX_DIM // 4
TOPK_MAX = 256
Q_BLOCK = 128
D_RNN = (4 * D_MODEL // 3) // 256 * 256
LRU_BLOCKS = 16
LRU_BLOCK = D_RNN // LRU_BLOCKS
CONV_WIDTH = 4
LRU_C = 8.0
D_FF = (8 * D_MODEL // 3 + 255) // 256 * 256
LN_EPS = 1e-5
DN_ALPHA = (2.0 * DEPTH) ** 0.25
DN_BETA = (8.0 * DEPTH) ** -0.25

IN_WIDTHS = (N_HEADS * HEAD_DIM, N_KV_HEADS * HEAD_DIM, N_KV_HEADS * HEAD_DIM,
             N_IDX_HEADS * IDX_DIM, IDX_DIM, N_IDX_HEADS, D_RNN, D_RNN, 2 * D_MODEL)
IN_TOTAL = sum(IN_WIDTHS)

kernel_name = "hybrid_dsa_rglru_macaron_deepnorm"


def layer_norm(x, g, b):
    xf = x.astype(jnp.float32)
    mu = jnp.mean(xf, axis=-1, keepdims=True)
    var = jnp.mean(jnp.square(xf - mu), axis=-1, keepdims=True)
    y = (xf - mu) * lax.rsqrt(var + LN_EPS) * g.astype(jnp.float32) + b.astype(jnp.float32)
    return y.astype(x.dtype)


def swiglu(h, w_in, w_out):
    a, b = jnp.split(h @ w_in, 2, axis=-1)
    return (jax.nn.silu(a) * b) @ w_out


def rope(t, positions, rot_dim):
    half = rot_dim // 2
    inv_freq = jnp.power(ROPE_THETA, -(jnp.arange(half, dtype=jnp.float32) * 2.0 / rot_dim))
    ang = positions.astype(jnp.float32)[..., None] * inv_freq
    cos = jnp.cos(ang)[:, :, None, :].astype(t.dtype)
    sin = jnp.sin(ang)[:, :, None, :].astype(t.dtype)
    t1 = t[..., :half]
    t2 = t[..., half:rot_dim]
    return jnp.concatenate([t1 * cos - t2 * sin, t2 * cos + t1 * sin, t[..., rot_dim:]], axis=-1)


def split_cols(p):
    offs = []
    acc = 0
    for w in IN_WIDTHS[:-1]:
        acc += w
        offs.append(acc)
    return jnp.split(p, offs, axis=-1)


def dsa_attention(q, k, v, qi, ki, wi):
    B, S = q.shape[0], q.shape[1]
    topk = min(TOPK_MAX, S // 4)
    nb = S // Q_BLOCK
    G = N_HEADS // N_KV_HEADS
    qg = q.reshape(B, S, N_KV_HEADS, G, HEAD_DIM)
    key_pos = jnp.arange(S)
    scale = HEAD_DIM ** -0.5
    gather = jax.vmap(lambda t, i: t[i])

    def blocks(a):
        return a.reshape((B, nb, Q_BLOCK) + a.shape[2:]).swapaxes(0, 1)

    def one_block(args):
        start, qb, qib, wib = args
        qpos = start + jnp.arange(Q_BLOCK)
        causal = key_pos[None, :] <= qpos[:, None]
        logits = jnp.einsum('bqhd,bsd->bqhs', qib, ki).astype(jnp.float32)
        score = jnp.einsum('bqhs,bqh->bqs', jax.nn.relu(logits), wib.astype(jnp.float32))
        score = jnp.where(causal[None], score, -jnp.inf)
        _, idx = lax.top_k(score, topk)
        valid = idx <= qpos[None, :, None]
        k_sel = gather(k, idx)
        v_sel = gather(v, idx)
        s = jnp.einsum('bqhgd,bqkhd->bqhgk', qb, k_sel).astype(jnp.float32) * scale
        s = jnp.where(valid[:, :, None, None, :], s, -jnp.inf)
        p = jax.nn.softmax(s, axis=-1).astype(v.dtype)
        o = jnp.einsum('bqhgk,bqkhd->bqhgd', p, v_sel)
        return o.reshape(B, Q_BLOCK, N_HEADS * HEAD_DIM)

    starts = jnp.arange(nb) * Q_BLOCK
    out = lax.map(one_block, (starts, blocks(qg), blocks(qi), blocks(wi)))
    return out.swapaxes(0, 1).reshape(B, S, N_HEADS * HEAD_DIM)


def rglru_branch(rx, rg, conv_w, conv_b, wa, ba, wx, bx, lam):
    B, S = rx.shape[0], rx.shape[1]
    xc = lax.conv_general_dilated(
        rx, conv_w[:, None, :], window_strides=(1,), padding=[(CONV_WIDTH - 1, 0)],
        dimension_numbers=('NWC', 'WIO', 'NWC'), feature_group_count=D_RNN) + conv_b
    xb = xc.reshape(B, S, LRU_BLOCKS, LRU_BLOCK)
    r = jax.nn.sigmoid(jnp.einsum('btnc,ncd->btnd', xb, wa).reshape(B, S, D_RNN) + ba)
    i = jax.nn.sigmoid(jnp.einsum('btnc,ncd->btnd', xb, wx).reshape(B, S, D_RNN) + bx)
    log_a = -LRU_C * r.astype(jnp.float32) * jax.nn.softplus(-lam.astype(jnp.float32))
    a = jnp.exp(log_a)
    b = jnp.sqrt(-jnp.expm1(2.0 * log_a)) * (i * xc).astype(jnp.float32)

    def combine(left, right):
        a1, b1 = left
        a2, b2 = right
        return a1 * a2, a2 * b1 + b2

    _, hseq = lax.associative_scan(combine, (a, b), axis=1)
    return hseq.astype(rx.dtype) * jax.nn.gelu(rg)


def setup_inputs(seed: int = 0) -> dict:
    key = jax.random.key(seed)
    ks = jax.random.split(key, 24)
    f32 = jnp.float32
    L = DEPTH

    def nrm(k, shape, fan_in, mult=1.0):
        return jax.random.normal(k, shape, f32) * (fan_in ** -0.5) * mult

    def gain(k):
        return 1.0 + 0.02 * jax.random.normal(k, (L, D_MODEL), f32)

    def bias(k, n):
        return 0.02 * jax.random.normal(k, (L, n), f32)

    u = jax.random.uniform(ks[13], (L, D_RNN), f32, minval=0.9, maxval=0.999)
    s = u ** (1.0 / LRU_C)
    lru_lambda = jnp.log(s) - jnp.log1p(-s)
    return {
        "x": jax.random.normal(ks[0], (BATCH, SEQ, D_MODEL), f32),
        "positions": jnp.tile(jnp.arange(SEQ, dtype=jnp.int32)[None, :], (BATCH, 1)),
        "ffn1_w_in": nrm(ks[1], (L, D_MODEL, 2 * D_FF), D_MODEL),
        "ffn1_w_out": nrm(ks[2], (L, D_FF, D_MODEL), D_FF, DN_BETA),
        "ln1_g": gain(ks[3]),
        "ln1_b": bias(ks[4], D_MODEL),
        "w_in": nrm(ks[5], (L, D_MODEL, IN_TOTAL), D_MODEL),
        "conv_w": nrm(ks[6], (L, CONV_WIDTH, D_RNN), CONV_WIDTH),
        "conv_b": bias(ks[7], D_RNN),
        "lru_wa": nrm(ks[8], (L, LRU_BLOCKS, LRU_BLOCK, LRU_BLOCK), LRU_BLOCK),
        "lru_ba": bias(ks[9], D_RNN),
        "lru_wx": nrm(ks[10], (L, LRU_BLOCKS, LRU_BLOCK, LRU_BLOCK), LRU_BLOCK),
        "lru_bx": bias(ks[11], D_RNN),
        "lru_lambda": lru_lambda,
        "w_attn_branch": nrm(ks[12], (L, N_HEADS * HEAD_DIM, D_MODEL), N_HEADS * HEAD_DIM),
        "w_rnn_branch": nrm(ks[14], (L, D_RNN, D_MODEL), D_RNN),
        "w_out": nrm(ks[15], (L, D_MODEL, D_MODEL), D_MODEL, DN_BETA),
        "ln2_g": gain(ks[16]),
        "ln2_b": bias(ks[17], D_MODEL),
        "ffn2_w_in": nrm(ks[18], (L, D_MODEL, 2 * D_FF), D_MODEL),
        "ffn2_w_out": nrm(ks[19], (L, D_FF, D_MODEL), D_FF, DN_BETA),
        "ln3_g": gain(ks[20]),
        "ln3_b": bias(ks[21], D_MODEL),
    }


def reference(x, positions, ffn1_w_in, ffn1_w_out, ln1_g, ln1_b, w_in, conv_w, conv_b,
              lru_wa, lru_ba, lru_wx, lru_bx, lru_lambda, w_attn_branch, w_rnn_branch, w_out,
              ln2_g, ln2_b, ffn2_w_in, ffn2_w_out, ln3_g, ln3_b):
    B, S, _ = x.shape
    h = x
    for l in range(DEPTH):
        h = layer_norm(DN_ALPHA * h + 0.5 * swiglu(h, ffn1_w_in[l], ffn1_w_out[l]), ln1_g[l], ln1_b[l])

        q, k, v, qi, ki, wi, rx, rg, gates = split_cols(h @ w_in[l])
        q = rope(q.reshape(B, S, N_HEADS, HEAD_DIM), positions, ROPE_DIM)
        k = rope(k.reshape(B, S, N_KV_HEADS, HEAD_DIM), positions, ROPE_DIM)
        v = v.reshape(B, S, N_KV_HEADS, HEAD_DIM)
        qi = rope(qi.reshape(B, S, N_IDX_HEADS, IDX_DIM), positions, IDX_ROPE_DIM)
        ki = rope(ki.reshape(B, S, 1, IDX_DIM), positions, IDX_ROPE_DIM)[:, :, 0, :]
        wi = wi * (N_IDX_HEADS ** -0.5 * IDX_DIM ** -0.5)
        y_attn = dsa_attention(q, k, v, qi, ki, wi)
        y_rnn = rglru_branch(rx, rg, conv_w[l], conv_b[l], lru_wa[l], lru_ba[l],
                             lru_wx[l], lru_bx[l], lru_lambda[l])
        g_attn, g_rnn = jnp.split(jax.nn.sigmoid(gates), 2, axis=-1)
        merged = g_attn * (y_attn @ w_attn_branch[l]) + g_rnn * (y_rnn @ w_rnn_branch[l])
        h = layer_norm(DN_ALPHA * h + merged @ w_out[l], ln2_g[l], ln2_b[l])

        h = layer_norm(DN_ALPHA * h + 0.5 * swiglu(h, ffn2_w_in[l], ffn2_w_out[l]), ln3_g[l], ln3_b[l])
    return h
```

```cpp
#include <hip/hip_runtime.h>
#include <cstdio>
#include <cstdint>

#define LAS __attribute__((address_space(3)))
#define GAS __attribute__((address_space(1)))
typedef _Float16 f16;
typedef _Float16 f16x8 __attribute__((ext_vector_type(8)));
typedef _Float16 f16x4 __attribute__((ext_vector_type(4)));
typedef _Float16 f16x2 __attribute__((ext_vector_type(2)));
typedef short s16x4 __attribute__((ext_vector_type(4)));
typedef float f32x4 __attribute__((ext_vector_type(4)));
typedef float f32x2 __attribute__((ext_vector_type(2)));
typedef float f32x16 __attribute__((ext_vector_type(16)));
typedef unsigned u32x4 __attribute__((ext_vector_type(4)));
typedef unsigned u32x2 __attribute__((ext_vector_type(2)));
typedef unsigned long long u64;

#ifndef MK_LAUNCHES
#define MK_LAUNCHES 1
#endif

constexpr int NB = 4, SEQ = 2048, T = NB * SEQ, D = 2048, DFF = 5632, NIN = 13392, NINP = 13568, DRNN = 2560, KCAT = 4608;
constexpr int NH = 16, NKV = 4, HD = 128, NIH = 16, IDD = 64, TOPK = 256;
constexpr int LRU_NB = 16, LRU_BS = 160;
constexpr float LN_EPS = 1e-5f;
constexpr float DN_ALPHA = 1.189207115002721f;
constexpr float QSCALE = 0.08838834764831845f * 1.4426950408889634f;
constexpr int NPHASE = 13;

constexpr size_t MiB = 1u << 20;
constexpr size_t WS_CTL = 0, CTL_BYTES = 1 * MiB;
constexpr size_t WS_TAB = 1 * MiB;
constexpr size_t TAB_COSQ = 0, TAB_SINQ = 512 * 1024, TAB_COSI = 1024 * 1024, TAB_SINI = 1280 * 1024, TAB_SPL = 1536 * 1024;
constexpr size_t WS_WAT = 3 * MiB, WS_WXT = 4 * MiB;
constexpr size_t WS_W1IN = 5 * MiB, WS_W1OUT = 49 * MiB;
constexpr size_t WS_MERGED = 5 * MiB;
constexpr size_t WS_WIN = 71 * MiB, WS_WCAT = 124 * MiB, WS_WOUT = 142 * MiB;
constexpr size_t WS_HB = 150 * MiB;
constexpr size_t WS_ACT = 182 * MiB;
constexpr size_t WS_GATES = 182 * MiB, WS_QI = 246 * MiB, WS_KI = 262 * MiB, WS_WI = 263 * MiB, WS_MASK = 264 * MiB;
constexpr size_t WS_R = 270 * MiB;
constexpr size_t WS_RX = 270 * MiB, WS_K = 310 * MiB, WS_V = 318 * MiB;
constexpr size_t WS_YCAT = 334 * MiB;
constexpr size_t WS_END = 406 * MiB;

constexpr int RING_BYTES = 131072;
constexpr int LDSCTL_OFF = 131072 + 8192;
constexpr int LDS_BYTES = 147456;

__device__ __forceinline__ unsigned pk2h(float lo, float hi) { f32x2 v = {lo, hi}; f16x2 h = __builtin_convertvector(v, f16x2); return __builtin_bit_cast(unsigned, h); }
__device__ __forceinline__ f32x4 h4_to_f4(u32x2 w) { f16x4 h = __builtin_bit_cast(f16x4, w); return __builtin_convertvector(h, f32x4); }
__device__ __forceinline__ float fast_rcp(float x) { return __builtin_amdgcn_rcpf(x); }
__device__ __forceinline__ float fast_exp2(float x) { return __builtin_amdgcn_exp2f(x); }
__device__ __forceinline__ float sigmoidf_(float x) { return fast_rcp(1.0f + fast_exp2(-1.4426950408889634f * x)); }
__device__ __forceinline__ float siluf_(float x) { return x * sigmoidf_(x); }
__device__ __forceinline__ float gelu_tanh_(float x) {
    const float u = 0.7978845608028654f * (x + 0.044715f * x * x * x);
    return x * sigmoidf_(2.0f * u);
}
#define VM_WAIT() asm volatile("s_waitcnt vmcnt(0)" ::: "memory")
#define LDS_WAIT() asm volatile("s_waitcnt lgkmcnt(0)" ::: "memory")

namespace pg8 {
constexpr int BM = 256, BK = 64, HALF = 128, HTB = HALF * BK * 2, STAGE_BYTES = 8 * HTB, NXCD = 8, WGM = 8;
__host__ __device__ __forceinline__ int lds_byte(int r, int c) { const int st = (r >> 4) * 2 + (c >> 5), rr = r & 15, cc = c & 31, ob = rr * 64 + cc * 2; return st * 1024 + (ob ^ (((ob >> 9) & 1) << 5)); }
__host__ __device__ __forceinline__ void stage_rc(int b, int& R, int& C) { const int st = b / 1024, sb = b % 1024, swz = sb ^ (((sb >> 9) & 1) << 5); R = (st >> 1) * 16 + swz / 64; C = (st & 1) * 32 + (swz % 64) / 2; }
struct Unit { int pm, pn; };
struct Gemm { const f16* A; const f16* Bt; int M, N, K; };
struct StaticOrder {
    int nM, nN, nwg, G, c;
    __host__ __device__ void init(int M, int N, int G_, int c_) { nM = M / BM; nN = N / BM; nwg = nM * nN; G = G_; c = c_; }
    __host__ __device__ bool next(int i, Unit& u) const {
        const long L = (long)i * G + c; if (L >= nwg) return false;
        int wgid = (int)L; { const int q = nwg / NXCD, r = nwg % NXCD, xcd = wgid % NXCD, off = wgid / NXCD; wgid = (xcd < r ? xcd * (q + 1) : r * (q + 1) + (xcd - r) * q) + off; }
        const int nig = WGM * nN, gid = wgid / nig, fm = gid * WGM, gsz = (nM - fm) < WGM ? (nM - fm) : WGM;
        u.pm = fm + ((wgid % nig) % gsz); u.pn = (wgid % nig) / gsz; return true;
    }
};
template <class Epi, int MIDT>
__device__ __forceinline__ void gemm_phase(LAS unsigned char* lds, const Gemm g, const StaticOrder& S, const Epi& E) {
    const int tid = threadIdx.x, wid = __builtin_amdgcn_readfirstlane(tid >> 6), lane = tid & 63, wr = wid >> 2, wc = wid & 3, fr = lane & 15, fq = lane >> 4;
    const int K = g.K, nt = K / BK;
    unsigned voffA[2];
#pragma unroll
    for (int i = 0; i < 2; ++i) { int R, C; stage_rc(tid * 16 + i * 8192, R, C); voffA[i] = (unsigned)(R * K + C) * 2u; }
    const size_t kstep = (size_t)(BK * 2);
    const size_t hstep = (size_t)HALF * K * 2;
    const size_t tstep = 2 * hstep;
    const unsigned ldsw = (unsigned)wid * 1024u;
    const int aoff = lds_byte(wr * 64 + fr, fq * 8), boff = lds_byte(wc * 32 + fr, fq * 8);
#define PG8_SA(b, h) (((b) * 2 + (h)) * HTB)
#define PG8_SB(b, h) ((4 + (b) * 2 + (h)) * HTB)
#define PG8_STAGE(bufoff, gbase) do { _Pragma("unroll") for (int _i = 0; _i < 2; ++_i) \
        __builtin_amdgcn_global_load_lds((const unsigned*)((const char*)(gbase) + voffA[_i]), (LAS unsigned*)(lds + (bufoff) + ldsw + _i * 8192), 16, 0, 0); } while (0)
#define PG8_LDA(dst, b, h) do { _Pragma("unroll") for (int m = 0; m < 4; ++m) _Pragma("unroll") for (int k = 0; k < 2; ++k) dst[m][k] = *(const LAS f16x8*)(lds + PG8_SA(b, h) + aoff + m * 2048 + k * 1024); } while (0)
#define PG8_LDB(dst, b, h) do { _Pragma("unroll") for (int n = 0; n < 2; ++n) _Pragma("unroll") for (int k = 0; k < 2; ++k) dst[n][k] = *(const LAS f16x8*)(lds + PG8_SB(b, h) + boff + n * 2048 + k * 1024); } while (0)
#define PG8_MMA(ai, bj, At, Bt) do { __builtin_amdgcn_s_setprio(1); _Pragma("unroll") for (int m = 0; m < 4; ++m) _Pragma("unroll") for (int n = 0; n < 2; ++n) _Pragma("unroll") for (int k = 0; k < 2; ++k) \
        acc[ai][bj][m][n] = __builtin_amdgcn_mfma_f32_16x16x32_f16(Bt[n][k], At[m][k], acc[ai][bj][m][n], 0, 0, 0); __builtin_amdgcn_s_setprio(0); } while (0)
#define PG8_WAIT_V(n) asm volatile("s_waitcnt vmcnt(" #n ")" ::: "memory")
#define PG8_WAIT_L(n) asm volatile("s_waitcnt lgkmcnt(" #n ")" ::: "memory")
#define PG8_BAR __builtin_amdgcn_s_barrier()
#define PG8_SCHED __builtin_amdgcn_sched_barrier(0)
    Unit cur, nxt; int ui = 0;
    if (!S.next(0, cur)) return;
    f32x4 acc[2][2][4][2];
#pragma unroll
    for (int a = 0; a < 2; ++a)
#pragma unroll
        for (int b = 0; b < 2; ++b)
#pragma unroll
            for (int m = 0; m < 4; ++m)
#pragma unroll
                for (int n = 0; n < 2; ++n) acc[a][b][m][n] = (f32x4){0.f, 0.f, 0.f, 0.f};
    f16x8 At[4][2], B0[2][2], B1[2][2];
    const char* cA = (const char*)g.A + (size_t)cur.pm * tstep; const char* cB = (const char*)g.Bt + (size_t)cur.pn * tstep;
    PG8_STAGE(PG8_SB(0, 0), cB); PG8_STAGE(PG8_SB(0, 1), cB + hstep); PG8_STAGE(PG8_SA(0, 0), cA); PG8_STAGE(PG8_SA(0, 1), cA + hstep);
    if (wr == 1) PG8_BAR;
    PG8_WAIT_V(2); PG8_BAR;
    PG8_STAGE(PG8_SB(1, 0), cB + kstep); PG8_STAGE(PG8_SA(1, 0), cA + kstep); PG8_STAGE(PG8_SB(1, 1), cB + hstep + kstep);
    PG8_WAIT_V(6); PG8_BAR;
    for (;;) {
        const bool has_next = S.next(ui + 1, nxt);
        const char* nA = has_next ? (const char*)g.A + (size_t)nxt.pm * tstep : cA; const char* nB = has_next ? (const char*)g.Bt + (size_t)nxt.pn * tstep : cB;
        for (int t = 0; t < nt; t += 2) {
            const bool last = (t == nt - 2);
            const char* a1 = cA + (size_t)(t + 1) * kstep;
            const char* a2 = last ? nA : cA + (size_t)(t + 2) * kstep; const char* b2 = last ? nB : cB + (size_t)(t + 2) * kstep;
            const char* a3 = a2 + kstep; const char* b3 = b2 + kstep;
            if constexpr (MIDT > 0) { if (t == MIDT) E.mid(acc, cur, wr, wc, fr, fq); }
            PG8_LDB(B0, 0, 0); PG8_LDB(B1, 0, 1); PG8_SCHED; PG8_LDA(At, 0, 0); PG8_STAGE(PG8_SA(1, 1), a1 + hstep);
            PG8_WAIT_V(8); PG8_WAIT_L(0); PG8_BAR; PG8_MMA(0, 0, At, B0); PG8_MMA(0, 1, At, B1); PG8_BAR; PG8_SCHED;
            PG8_LDA(At, 0, 1); PG8_STAGE(PG8_SB(0, 0), b2); PG8_STAGE(PG8_SB(0, 1), b2 + hstep); PG8_STAGE(PG8_SA(0, 0), a2);
            PG8_WAIT_V(8); PG8_WAIT_L(0); PG8_BAR; PG8_MMA(1, 0, At, B0); PG8_MMA(1, 1, At, B1); PG8_BAR; PG8_SCHED;
            PG8_LDB(B0, 1, 0); PG8_LDB(B1, 1, 1); PG8_SCHED; PG8_LDA(At, 1, 0); PG8_STAGE(PG8_SA(0, 1), a2 + hstep);
            PG8_WAIT_V(8); PG8_WAIT_L(0); PG8_BAR; PG8_MMA(0, 0, At, B0); PG8_MMA(0, 1, At, B1); PG8_BAR; PG8_SCHED;
            PG8_LDA(At, 1, 1); PG8_STAGE(PG8_SB(1, 0), b3); PG8_STAGE(PG8_SB(1, 1), b3 + hstep); PG8_STAGE(PG8_SA(1, 0), a3);
            PG8_WAIT_V(8); PG8_WAIT_L(0); PG8_BAR; PG8_MMA(1, 0, At, B0); PG8_MMA(1, 1, At, B1); PG8_BAR; PG8_SCHED;
        }
        if (wr == 0) PG8_BAR;
        E(acc, cur, wr, wc, fr, fq);
        if (!has_next) break;
#pragma unroll
        for (int a = 0; a < 2; ++a)
#pragma unroll
            for (int b = 0; b < 2; ++b)
#pragma unroll
                for (int m = 0; m < 4; ++m)
#pragma unroll
                    for (int n = 0; n < 2; ++n) acc[a][b][m][n] = (f32x4){0.f, 0.f, 0.f, 0.f};
        cur = nxt; cA = nA; cB = nB; ++ui;
        if (wr == 1) PG8_BAR;
    }
    PG8_WAIT_V(0);
    PG8_BAR;
#undef PG8_SA
#undef PG8_SB
#undef PG8_STAGE
#undef PG8_LDA
#undef PG8_LDB
#undef PG8_MMA
#undef PG8_WAIT_V
#undef PG8_WAIT_L
#undef PG8_BAR
#undef PG8_SCHED
}
}
using pg8::Unit;
typedef const f32x4 (&AccRef)[2][2][4][2];

struct EpiSwiglu {
    f16* O;
    __device__ __forceinline__ void operator()(AccRef acc, const Unit& u, int wr, int wc, int fr, int fq) const {
        const int row0 = u.pm * 256 + wr * 64 + fr, col0 = u.pn * 128 + wc * 32 + 8 * fq;
#pragma unroll
        for (int ai = 0; ai < 2; ++ai)
#pragma unroll
            for (int m = 0; m < 4; ++m) {
                const f32x4 a0 = acc[ai][0][m][0], a1 = acc[ai][0][m][1], b0 = acc[ai][1][m][0], b1 = acc[ai][1][m][1];
                u32x4 w;
                w.x = pk2h(siluf_(a0[0]) * b0[0], siluf_(a0[1]) * b0[1]); w.y = pk2h(siluf_(a0[2]) * b0[2], siluf_(a0[3]) * b0[3]);
                w.z = pk2h(siluf_(a1[0]) * b1[0], siluf_(a1[1]) * b1[1]); w.w = pk2h(siluf_(a1[2]) * b1[2], siluf_(a1[3]) * b1[3]);
                *(u32x4*)(O + (size_t)(row0 + ai * 128 + m * 16) * DFF + col0) = w;
            }
    }
};
template <bool RESF32> struct EpiResid {
    const void* res; float* R; float alpha, beta;
    __device__ __forceinline__ void operator()(AccRef acc, const Unit& u, int wr, int wc, int fr, int fq) const {
        const int row0 = u.pm * 256 + wr * 64 + fr, col0 = u.pn * 256 + wc * 32 + 4 * fq;
#pragma unroll
        for (int ai = 0; ai < 2; ++ai)
#pragma unroll
            for (int m = 0; m < 4; ++m) {
                const size_t off = (size_t)(row0 + ai * 128 + m * 16) * D + col0;
#pragma unroll
                for (int bj = 0; bj < 2; ++bj)
#pragma unroll
                    for (int n = 0; n < 2; ++n) {
                        f32x4 rv;
                        if (RESF32) rv = *(const f32x4*)((const float*)res + off + bj * 128 + n * 16);
                        else rv = h4_to_f4(*(const u32x2*)((const f16*)res + off + bj * 128 + n * 16));
                        *(f32x4*)(R + off + bj * 128 + n * 16) = rv * alpha + acc[ai][bj][m][n] * beta;
                    }
            }
    }
};
struct EpiMixer {
    f16 *YCAT, *KB, *VB, *RX, *GATES, *QI, *KI; float* WI;
    const float *cosq, *sinq, *cosi, *sini;
    __device__ __forceinline__ void operator()(AccRef acc, const Unit& u, int wr, int wc, int fr, int fq) const {
        const int row0 = u.pm * 256 + wr * 64 + fr, pn = u.pn;
        if (pn < 10) {
            const int cn = wc * 32 + 4 * fq;
            const float sc = pn < 8 ? QSCALE : 1.0f;
#pragma unroll
            for (int ai = 0; ai < 2; ++ai)
#pragma unroll
                for (int m = 0; m < 4; ++m) {
                    const int row = row0 + ai * 128 + m * 16;
                    f32x4 cs = {1.f, 1.f, 1.f, 1.f}, sn = {0.f, 0.f, 0.f, 0.f};
                    if (wc == 0) { cs = *(const f32x4*)(cosq + (size_t)row * 16 + 4 * fq); sn = *(const f32x4*)(sinq + (size_t)row * 16 + 4 * fq); }
#pragma unroll
                    for (int bj = 0; bj < 2; ++bj) {
                        f32x4 v0 = acc[ai][bj][m][0], v1 = acc[ai][bj][m][1];
                        if (wc == 0) { const f32x4 t0 = v0 * cs - v1 * sn, t1 = v1 * cs + v0 * sn; v0 = t0; v1 = t1; }
                        v0 = v0 * sc; v1 = v1 * sc;
                        u32x2 w0, w1; w0.x = pk2h(v0[0], v0[1]); w0.y = pk2h(v0[2], v0[3]); w1.x = pk2h(v1[0], v1[1]); w1.y = pk2h(v1[2], v1[3]);
                        f16* p = pn < 8 ? YCAT + (size_t)row * KCAT + pn * 256 + bj * 128 + cn : KB + (size_t)row * 512 + (pn - 8) * 256 + bj * 128 + cn;
                        *(u32x2*)p = w0; *(u32x2*)(p + 16) = w1;
                    }
                }
        } else if (pn < 48) {
            const int cn = wc * 32 + 8 * fq;
            f16* base; int ldc, act;
            if (pn < 12) { base = VB + (pn - 10) * 256; ldc = 512; act = 0; }
            else if (pn < 22) { base = RX + (pn - 12) * 256; ldc = DRNN; act = 0; }
            else if (pn < 32) { base = YCAT + 2048 + (pn - 22) * 256; ldc = KCAT; act = 1; }
            else { base = GATES + (pn - 32) * 256; ldc = 4096; act = 2; }
#pragma unroll
            for (int ai = 0; ai < 2; ++ai)
#pragma unroll
                for (int m = 0; m < 4; ++m) {
                    const int row = row0 + ai * 128 + m * 16;
#pragma unroll
                    for (int bj = 0; bj < 2; ++bj) {
                        f32x4 v0 = acc[ai][bj][m][0], v1 = acc[ai][bj][m][1];
                        if (act == 1) {
#pragma unroll
                            for (int e = 0; e < 4; ++e) { v0[e] = gelu_tanh_(v0[e]); v1[e] = gelu_tanh_(v1[e]); }
                        } else if (act == 2) {
#pragma unroll
                            for (int e = 0; e < 4; ++e) { v0[e] = sigmoidf_(v0[e]); v1[e] = sigmoidf_(v1[e]); }
                        }
                        u32x4 w; w.x = pk2h(v0[0], v0[1]); w.y = pk2h(v0[2], v0[3]); w.z = pk2h(v1[0], v1[1]); w.w = pk2h(v1[2], v1[3]);
                        *(u32x4*)(base + (size_t)row * ldc + bj * 128 + cn) = w;
                    }
                }
        } else {
            const int cn = wc * 32 + 4 * fq;
            const bool rot = ((wc & 1) == 0) && (fq < 2);
#pragma unroll
            for (int ai = 0; ai < 2; ++ai)
#pragma unroll
                for (int m = 0; m < 4; ++m) {
                    const int row = row0 + ai * 128 + m * 16;
                    f32x4 cs = {1.f, 1.f, 1.f, 1.f}, sn = {0.f, 0.f, 0.f, 0.f};
                    if (rot) { cs = *(const f32x4*)(cosi + (size_t)row * 8 + 4 * fq); sn = *(const f32x4*)(sini + (size_t)row * 8 + 4 * fq); }
#pragma unroll
                    for (int bj = 0; bj < 2; ++bj) {
                        f32x4 v0 = acc[ai][bj][m][0], v1 = acc[ai][bj][m][1];
                        if (pn < 52) {
                            if (rot) { const f32x4 t0 = v0 * cs - v1 * sn, t1 = v1 * cs + v0 * sn; v0 = t0; v1 = t1; }
                            u32x2 w0, w1; w0.x = pk2h(v0[0], v0[1]); w0.y = pk2h(v0[2], v0[3]); w1.x = pk2h(v1[0], v1[1]); w1.y = pk2h(v1[2], v1[3]);
                            f16* p = QI + (size_t)row * 1024 + (pn - 48) * 256 + bj * 128 + cn;
                            *(u32x2*)p = w0; *(u32x2*)(p + 16) = w1;
                        } else if (bj == 0) {
                            if (wc < 2) {
                                if (rot) { const f32x4 t0 = v0 * cs - v1 * sn, t1 = v1 * cs + v0 * sn; v0 = t0; v1 = t1; }
                                u32x2 w0, w1; w0.x = pk2h(v0[0], v0[1]); w0.y = pk2h(v0[2], v0[3]); w1.x = pk2h(v1[0], v1[1]); w1.y = pk2h(v1[2], v1[3]);
                                f16* p = KI + (size_t)row * 64 + cn;
                                *(u32x2*)p = w0; *(u32x2*)(p + 16) = w1;
                            } else if (wc == 2) {
                                *(f32x4*)(WI + (size_t)row * 16 + 4 * fq) = v0 * 0.03125f;
                            }
                        }
                    }
                }
        }
    }
};
struct EpiMerged {
    const f16* GATES; f16* O;
    __device__ __forceinline__ void mid(f32x4 (&acc)[2][2][4][2], const Unit& u, int wr, int wc, int fr, int fq) const {
        int row0 = u.pm * 256 + wr * 64 + fr, col0 = u.pn * 256 + wc * 32 + 8 * fq;
        asm volatile("" : "+v"(row0), "+v"(col0));
#pragma unroll
        for (int ai = 0; ai < 2; ++ai)
#pragma unroll
            for (int m = 0; m < 4; ++m) {
                const f16* gp = GATES + (size_t)(row0 + ai * 128 + m * 16) * 4096 + col0;
#pragma unroll
                for (int bj = 0; bj < 2; ++bj) {
                    const u32x4 ga = *(const u32x4*)(gp + bj * 128), gr = *(const u32x4*)(gp + 2048 + bj * 128);
                    const f32x4 ga0 = h4_to_f4((u32x2){ga.x, ga.y}), ga1 = h4_to_f4((u32x2){ga.z, ga.w}), gr0 = h4_to_f4((u32x2){gr.x, gr.y}), gr1 = h4_to_f4((u32x2){gr.z, gr.w});
#pragma unroll
                    for (int e = 0; e < 4; ++e) { acc[ai][bj][m][0][e] *= ga0[e] * fast_rcp(gr0[e]); acc[ai][bj][m][1][e] *= ga1[e] * fast_rcp(gr1[e]); }
                }
                asm volatile("" : "+v"(acc[ai][0][m][0]), "+v"(acc[ai][0][m][1]), "+v"(acc[ai][1][m][0]), "+v"(acc[ai][1][m][1]) :: "memory");
            }
    }
    __device__ __forceinline__ void operator()(AccRef acc, const Unit& u, int wr, int wc, int fr, int fq) const {
        const int row0 = u.pm * 256 + wr * 64 + fr, col0 = u.pn * 256 + wc * 32 + 8 * fq;
#pragma unroll
        for (int ai = 0; ai < 2; ++ai)
#pragma unroll
            for (int m = 0; m < 4; ++m) {
                const size_t row = (size_t)(row0 + ai * 128 + m * 16);
#pragma unroll
                for (int bj = 0; bj < 2; ++bj) {
                    const u32x4 gr = *(const u32x4*)(GATES + row * 4096 + 2048 + col0 + bj * 128);
                    const f32x4 gr0 = h4_to_f4((u32x2){gr.x, gr.y}), gr1 = h4_to_f4((u32x2){gr.z, gr.w});
                    const f32x4 v0 = acc[ai][bj][m][0] * gr0, v1 = acc[ai][bj][m][1] * gr1;
                    u32x4 w; w.x = pk2h(v0[0], v0[1]); w.y = pk2h(v0[2], v0[3]); w.z = pk2h(v1[0], v1[1]); w.w = pk2h(v1[2], v1[3]);
                    *(u32x4*)(O + row * D + col0 + bj * 128) = w;
                }
            }
    }
};

#define XB_TMO      128
#define XB_XCNT(j)  (256  + 64 * (j))
#define XB_XSUB(j)  (1280 + 64 * (j))
#define XB_XGEN(j)  (2304 + 64 * (j))
#define XB_TOP      3328
#define XB_TOPGEN   3392
#define XCD_BAR_WORDS 3456
#define XB_SPIN_CAP (1u << 22)
__device__ __forceinline__ unsigned xb_ld(unsigned* p)              { return __hip_atomic_load(p, __ATOMIC_RELAXED, __HIP_MEMORY_SCOPE_AGENT); }
__device__ __forceinline__ unsigned xb_add(unsigned* p, unsigned v) { return __hip_atomic_fetch_add(p, v, __ATOMIC_RELAXED, __HIP_MEMORY_SCOPE_AGENT); }
__device__ __forceinline__ unsigned xb_xcc_id() { return (unsigned)__builtin_amdgcn_s_getreg((3 << 11) | 20) & 0xFu; }
#define XB_SPIN(cond, bar) do { unsigned _sp = 0; while (cond) { __builtin_amdgcn_s_sleep(1); \
    if ((++_sp & 255u) == 0u) { if (xb_ld(&(bar)[XB_TMO])) break; if (_sp > XB_SPIN_CAP) { atomicAdd(&(bar)[XB_TMO], 1u); break; } } } } while (0)
struct XcdBarrier { unsigned* bar; unsigned x; volatile LAS unsigned* st; };
__device__ __forceinline__ XcdBarrier xcd_barrier_post(unsigned* bar, volatile LAS unsigned* st) {
    XcdBarrier b; b.bar = bar; b.x = xb_xcc_id(); b.st = st;
    if (threadIdx.x == 0) (void)xb_add(&bar[XB_XCNT(b.x)], 1u);
    return b;
}
__device__ __forceinline__ void xcd_barrier_complete(unsigned* bar, unsigned x, unsigned& nloc, unsigned& nx) {
    const unsigned G = gridDim.x * gridDim.y * gridDim.z;
    unsigned sum, cnt, mine, sp = 0u;
    for (;;) {
        sum = 0u; cnt = 0u; mine = 0u;
#pragma unroll
        for (unsigned j = 0; j < 16; ++j) { const unsigned c = xb_ld(&bar[XB_XCNT(j)]); sum += c; cnt += (c > 0u) ? 1u : 0u; mine = (j == x) ? c : mine; }
        if (sum == G) break;
        __builtin_amdgcn_s_sleep(1);
        if ((++sp & 255u) == 0u) { if (xb_ld(&bar[XB_TMO])) break; if (sp > XB_SPIN_CAP) { atomicAdd(&bar[XB_TMO], 1u); break; } }
    }
    nloc = mine > 0u ? mine : 1u; nx = cnt > 0u ? cnt : 1u;
}
__device__ __forceinline__ void xcd_barrier(const XcdBarrier& b) {
    asm volatile("s_waitcnt vmcnt(0)" ::: "memory");
    __syncthreads();
    if (threadIdx.x == 0) {
        unsigned* bar = b.bar;
        __builtin_amdgcn_s_waitcnt(0);
        unsigned nloc = b.st[0], nx = b.st[1];
        if (nloc == 0u) { xcd_barrier_complete(bar, b.x, nloc, nx); b.st[0] = nloc; b.st[1] = nx; }
        const unsigned old = xb_add(&bar[XB_XSUB(b.x)], 1u);
        const unsigned gen = old / nloc;
        if (old + 1u == (gen + 1u) * nloc) {
            __builtin_amdgcn_fence(__ATOMIC_RELEASE, "agent");
            asm volatile("s_waitcnt vmcnt(0)" ::: "memory");
            const unsigned og = xb_add(&bar[XB_TOP], 1u);
            const unsigned tg = og / nx;
            if (og + 1u == (tg + 1u) * nx) xb_add(&bar[XB_TOPGEN], 1u);
            else XB_SPIN(xb_ld(&bar[XB_TOPGEN]) == tg, bar);
            __builtin_amdgcn_fence(__ATOMIC_ACQUIRE, "agent");
            xb_add(&bar[XB_XGEN(b.x)], 1u);
            asm volatile("s_waitcnt vmcnt(0)" ::: "memory");
        } else {
            XB_SPIN(xb_ld(&bar[XB_XGEN(b.x)]) == gen, bar);
            __builtin_amdgcn_fence(__ATOMIC_ACQUIRE, "agent");
            asm volatile("s_waitcnt vmcnt(0)" ::: "memory");
        }
    }
    __syncthreads();
}

struct Args { const float* in[23]; float* out; unsigned char* ws; int ph_lo, ph_hi; };
struct Frame {
    LAS unsigned char* lds;
    int tid, lane, wave, vcu, G;
    const Args* a;
    unsigned char* ws;
};
#define WSP(T_, off) ((T_*)(F.ws + (off)))

__device__ __forceinline__ float wave_sum(float v) {
#pragma unroll
    for (int o = 1; o < 64; o <<= 1) v += __shfl_xor(v, o);
    return v;
}

__device__ __forceinline__ int destpos(int j, int ptype) {
    if (ptype == 1) return ((j >> 2) & 1) * 16 + ((j >> 3) << 2) + (j & 3);
    if (ptype == 2) return j < 8 ? j : (j < 16 ? j + 8 : (j < 24 ? j - 8 : j));
    return j;
}
__device__ __forceinline__ void tr_item(const float* W, int ldw, int k0, f16* WT, int ldt, int kdst0, int nrow0, int sbase, int valid, int ptype, LAS float* scr, int lane) {
    const int j = lane & 31, dp = destpos(j, ptype);
#pragma unroll 8
    for (int i = 0; i < 32; ++i) { const int kk = 2 * i + (lane >> 5); scr[kk * 33 + dp] = (j < valid) ? W[(size_t)(k0 + kk) * ldw + sbase + j] : 0.f; }
    LDS_WAIT(); asm volatile("" ::: "memory");
    const int c = lane & 7;
#pragma unroll
    for (int jj = 0; jj < 4; ++jj) { const int n = (lane >> 3) + 8 * jj; const LAS float* s = scr + (8 * c) * 33 + n;
        u32x4 o; o.x = pk2h(s[0 * 33], s[1 * 33]); o.y = pk2h(s[2 * 33], s[3 * 33]); o.z = pk2h(s[4 * 33], s[5 * 33]); o.w = pk2h(s[6 * 33], s[7 * 33]);
        *(u32x4*)(WT + (size_t)(nrow0 + n) * ldt + kdst0 + k0 + 8 * c) = o; }
    LDS_WAIT(); asm volatile("" ::: "memory");
}
__device__ __forceinline__ void convert_ffn(Frame& F, const float* w_in, const float* w_out, f16* WINT, f16* WOUTT) {
    LAS float* scr = (LAS float*)(F.lds + F.wave * 16384);
    const int gw = F.vcu * 8 + F.wave, NGW = F.G * 8;
    constexpr int I_IN = (D / 64) * (2 * DFF / 32), I_OUT = (DFF / 64) * (D / 32);
    for (int it = gw; it < I_IN + I_OUT; it += NGW) {
        if (it < I_IN) {
            const int G = it % (2 * DFF / 32), kb = it / (2 * DFF / 32);
            const int pn = G >> 3, g8 = G & 7, bj = g8 >> 2, g = g8 & 3;
            tr_item(w_in, 2 * DFF, kb * 64, WINT, D, 0, G * 32, bj * DFF + pn * 128 + g * 32, 32, 1, scr, F.lane);
        } else {
            const int r = it - I_IN, G = r % (D / 32), kb = r / (D / 32);
            tr_item(w_out, D, kb * 64, WOUTT, DFF, 0, G * 32, G * 32, 32, 0, scr, F.lane);
        }
    }
}

__device__ __forceinline__ void p0_prologue(Frame& F) {
    const Args& A = *F.a;
    convert_ffn(F, A.in[2], A.in[3], WSP(f16, WS_W1IN), WSP(f16, WS_W1OUT));
    LAS float* scr = (LAS float*)(F.lds + F.wave * 16384);
    const int gw = F.vcu * 8 + F.wave, NGW = F.G * 8;
    {
        const float* W = A.in[6]; f16* WT = WSP(f16, WS_WIN);
        constexpr int NG = NINP / 32, I_W = (D / 64) * NG;
        for (int it = gw; it < I_W; it += NGW) {
            const int G = it % NG, kb = it / NG, tile = G >> 3;
            int sbase, valid = 32, ptype;
            if (tile < 10) { sbase = G * 32; ptype = 0; }
            else if (tile < 12) { sbase = G * 32; ptype = 1; }
            else if (tile < 48) { sbase = G * 32 + 1104; ptype = 1; }
            else if (tile < 52) { sbase = 3072 + (G * 32 - 12288); ptype = (G & 1) ? 0 : 2; }
            else { const int g8 = G - 416; if (g8 == 0) { sbase = 4096; ptype = 2; } else if (g8 == 1) { sbase = 4128; ptype = 0; } else if (g8 == 2) { sbase = 4160; valid = 16; ptype = 0; } else { sbase = 0; valid = 0; ptype = 0; } }
            tr_item(W, NIN, kb * 64, WT, D, 0, G * 32, sbase, valid, ptype, scr, F.lane);
        }
    }
    {
        f16* WC = WSP(f16, WS_WCAT); f16* WO = WSP(f16, WS_WOUT);
        constexpr int NG = D / 32, I_A = (D / 64) * NG, I_R = (DRNN / 64) * NG, I_O = (D / 64) * NG;
        for (int it = gw; it < I_A + I_R + I_O; it += NGW) {
            int r = it;
            if (r < I_A) { const int G = r % NG, kb = r / NG; tr_item(A.in[14], D, kb * 64, WC, KCAT, 0, G * 32, G * 32, 32, 1, scr, F.lane); continue; } r -= I_A;
            if (r < I_R) { const int G = r % NG, kb = r / NG; tr_item(A.in[15], D, kb * 64, WC, KCAT, 2048, G * 32, G * 32, 32, 1, scr, F.lane); continue; } r -= I_R;
            { const int G = r % NG, kb = r / NG; tr_item(A.in[16], D, kb * 64, WO, D, 0, G * 32, G * 32, 32, 0, scr, F.lane); }
        }
    }
    const int gt = F.vcu * 512 + F.tid, NGT = F.G * 512;
    {
        f16* WA = WSP(f16, WS_WAT); f16* WX = WSP(f16, WS_WXT);
        for (int i = gt; i < 2 * LRU_NB * LRU_BS * LRU_BS; i += NGT) {
            const int mat = i / (LRU_NB * LRU_BS * LRU_BS), r = i % (LRU_NB * LRU_BS * LRU_BS), n = r / (LRU_BS * LRU_BS), dc = r % (LRU_BS * LRU_BS), d = dc / LRU_BS, c = dc % LRU_BS;
            const float v = (mat ? A.in[11] : A.in[9])[(size_t)n * LRU_BS * LRU_BS + c * LRU_BS + d];
            (mat ? WX : WA)[r] = (f16)v;
        }
    }
    {
        const f32x4* x4 = (const f32x4*)A.in[0]; u32x2* xb = WSP(u32x2, WS_HB);
        for (int i = gt; i < T * D / 4; i += NGT) { const f32x4 v = x4[i]; u32x2 w; w.x = pk2h(v[0], v[1]); w.y = pk2h(v[2], v[3]); xb[i] = w; }
    }
    {
        const int* pos = (const int*)A.in[1];
        float* cq = (float*)(F.ws + WS_TAB + TAB_COSQ); float* sq = (float*)(F.ws + WS_TAB + TAB_SINQ);
        float* ci = (float*)(F.ws + WS_TAB + TAB_COSI); float* si = (float*)(F.ws + WS_TAB + TAB_SINI);
        for (int i = gt; i < T * 24; i += NGT) {
            const int tok = i / 24, j = i % 24;
            const float p = (float)pos[tok];
            if (j < 16) { const float inv = powf(500000.0f, -((float)j * 2.0f / 32.0f)); const float ang = p * inv; cq[tok * 16 + j] = cosf(ang); sq[tok * 16 + j] = sinf(ang); }
            else { const int jj = j - 16; const float inv = powf(500000.0f, -((float)jj * 2.0f / 16.0f)); const float ang = p * inv; ci[tok * 8 + jj] = cosf(ang); si[tok * 8 + jj] = sinf(ang); }
        }
        float* spl = (float*)(F.ws + WS_TAB + TAB_SPL);
        for (int i = gt; i < DRNN; i += NGT) { const float lam = A.in[13][i]; spl[i] = -8.0f * log1pf(expf(-lam)); }
    }
}

__device__ __forceinline__ void ln_phase(Frame& F, const float* R, const float* g, const float* b, f16* outh, float* outf) {
    const int gw = F.vcu * 8 + F.wave, NGW = F.G * 8;
    for (int row = gw; row < T; row += NGW) {
        const f32x4* xr = (const f32x4*)(R + (size_t)row * D) + F.lane;
        f32x4 v[8]; float s = 0.f;
#pragma unroll
        for (int j = 0; j < 8; ++j) { v[j] = xr[64 * j]; s += (v[j][0] + v[j][1]) + (v[j][2] + v[j][3]); }
        const float mean = wave_sum(s) * (1.f / D); float s2 = 0.f;
#pragma unroll
        for (int j = 0; j < 8; ++j) { v[j] = v[j] - mean; s2 += (v[j][0] * v[j][0] + v[j][1] * v[j][1]) + (v[j][2] * v[j][2] + v[j][3] * v[j][3]); }
        const float rstd = 1.0f / sqrtf(wave_sum(s2) * (1.f / D) + LN_EPS);
#pragma unroll
        for (int j = 0; j < 8; ++j) {
            const f32x4 gg = ((const f32x4*)g)[64 * j + F.lane], bb = ((const f32x4*)b)[64 * j + F.lane];
            const f32x4 o = v[j] * rstd * gg + bb;
            if (outf) ((f32x4*)(outf + (size_t)row * D))[64 * j + F.lane] = o;
            else { u32x2 w; w.x = pk2h(o[0], o[1]); w.y = pk2h(o[2], o[3]); ((u32x2*)(outh + (size_t)row * D))[64 * j + F.lane] = w; }
        }
    }
}

constexpr int SROW = 2052;
__device__ __forceinline__ unsigned f2key(float f) { const unsigned u = __builtin_bit_cast(unsigned, f); return (u & 0x80000000u) ? ~u : (u | 0x80000000u); }
__device__ __forceinline__ void indexer_item(Frame& F, int b, int qb) {
    const f16* QI = WSP(f16, WS_QI); const f16* KI = WSP(f16, WS_KI); const float* WI = WSP(float, WS_WI); u64* MASK = WSP(u64, WS_MASK);
    LAS float* S = (LAS float*)F.lds;
    const int lane = F.lane, wave = F.wave, c16 = lane & 15, g4 = lane >> 4;
    const int q0 = qb * 16, tok = b * SEQ + q0 + c16;
    f16x8 qf[16][2];
#pragma unroll
    for (int h = 0; h < 16; ++h)
#pragma unroll
        for (int ks = 0; ks < 2; ++ks) qf[h][ks] = *(const f16x8*)(QI + (size_t)tok * 1024 + h * 64 + ks * 32 + g4 * 8);
    float wq[16];
#pragma unroll
    for (int h4 = 0; h4 < 4; ++h4) { const f32x4 w = *(const f32x4*)(WI + (size_t)tok * 16 + h4 * 4); wq[h4 * 4 + 0] = w[0]; wq[h4 * 4 + 1] = w[1]; wq[h4 * 4 + 2] = w[2]; wq[h4 * 4 + 3] = w[3]; }
    const int nkt = qb + 1;
    for (int kt = wave; kt < nkt; kt += 8) {
        const f16* kp = KI + (size_t)(b * SEQ + kt * 16 + c16) * 64 + g4 * 8;
        const f16x8 k0 = *(const f16x8*)kp, k1 = *(const f16x8*)(kp + 32);
        f32x4 sc = {0.f, 0.f, 0.f, 0.f};
#pragma unroll
        for (int h = 0; h < 16; ++h) {
            f32x4 z = {0.f, 0.f, 0.f, 0.f};
            z = __builtin_amdgcn_mfma_f32_16x16x32_f16(k0, qf[h][0], z, 0, 0, 0);
            z = __builtin_amdgcn_mfma_f32_16x16x32_f16(k1, qf[h][1], z, 0, 0, 0);
#pragma unroll
            for (int e = 0; e < 4; ++e) sc[e] += wq[h] * fmaxf(z[e], 0.f);
        }
        *(LAS f32x4*)(S + c16 * SROW + kt * 16 + g4 * 4) = sc;
    }
    __syncthreads();
    for (int rr = wave; rr < 16; rr += 8) {
        const int t = q0 + rr;
        const LAS float* row = S + rr * SROW;
        u64* mrow = MASK + (size_t)(b * SEQ + t) * 32;
        if (t < TOPK) {
            for (int i = 0; i < 32; ++i) { const u64 m = __ballot(64 * i + lane <= t); if (lane == 0) mrow[i] = m; }
        } else {
            unsigned key[32];
#pragma unroll
            for (int i = 0; i < 32; ++i) { const int k = 64 * i + lane; key[i] = (k <= t) ? f2key(row[k]) : 0u; }
            unsigned thr = 0u;
            for (int bit = 31; bit >= 0; --bit) {
                const unsigned cand = thr | (1u << bit);
                int cnt = 0;
#pragma unroll
                for (int i = 0; i < 32; ++i) cnt += (key[i] >= cand) ? 1 : 0;
#pragma unroll
                for (int o = 1; o < 64; o <<= 1) cnt += __shfl_xor(cnt, o);
                if (cnt >= TOPK) thr = cand;
            }
            int cgt = 0;
#pragma unroll
            for (int i = 0; i < 32; ++i) cgt += (key[i] > thr) ? 1 : 0;
#pragma unroll
            for (int o = 1; o < 64; o <<= 1) cgt += __shfl_xor(cgt, o);
            int need = TOPK - cgt;
#pragma unroll
            for (int i = 0; i < 32; ++i) {
                const u64 eq = __ballot(key[i] == thr);
                const int before = __popcll(eq & ((1ull << lane) - 1ull));
                const bool sel = (key[i] > thr) || (key[i] == thr && before < need);
                need -= __popcll(eq);
                const u64 m = __ballot(sel);
                if (lane == 0) mrow[i] = m;
            }
        }
    }
    __syncthreads();
}
__device__ __forceinline__ void indexer_phase(Frame& F) {
    if (F.vcu >= 256) return;
    const int b = F.vcu >> 6, w = F.vcu & 63;
    for (int rep = 0; rep < 2; ++rep) {
        for (int vv = F.vcu; vv < 256; vv += F.G) {
            const int bb = vv >> 6, ww = vv & 63;
            indexer_item(F, bb, rep == 0 ? ww : 127 - ww);
        }
    }
    (void)b; (void)w;
}

constexpr int TC = 64, XROW = 168;
constexpr int RL_X16 = 0, RL_A = 21504, RL_B = RL_A + TC * LRU_BS * 4;
__device__ __forceinline__ void rnn_item(Frame& F, int b, int n) {
    const Args& A = *F.a;
    const f16* RX = WSP(f16, WS_RX); f16* YC = WSP(f16, WS_YCAT);
    const f16* WAT = WSP(f16, WS_WAT) + (size_t)n * LRU_BS * LRU_BS; const f16* WXT = WSP(f16, WS_WXT) + (size_t)n * LRU_BS * LRU_BS;
    const float* convw = A.in[7]; const float* convb = A.in[8]; const float* ba = A.in[10]; const float* bx = A.in[12];
    const float* spl = (const float*)(F.ws + WS_TAB + TAB_SPL);
    LAS f16* X16 = (LAS f16*)(F.lds + RL_X16); LAS float* LA = (LAS float*)(F.lds + RL_A); LAS float* LB = (LAS float*)(F.lds + RL_B);
    const int tid = F.tid, lane = F.lane, wave = F.wave, c16 = lane & 15, g4 = lane >> 4;
    const int ch0 = n * LRU_BS;
    float hcarry = 0.f;
    for (int ck = 0; ck < SEQ / TC; ++ck) {
        const int s0 = ck * TC;
        for (int it = tid; it < TC * (LRU_BS / 8); it += 512) {
            const int tk = it / (LRU_BS / 8), cg = it % (LRU_BS / 8), c = ch0 + cg * 8, s = s0 + tk;
            float xc[8];
#pragma unroll
            for (int e = 0; e < 8; ++e) xc[e] = convb[c + e];
#pragma unroll
            for (int j = 0; j < 4; ++j) {
                const int ss = s - 3 + j;
                if (ss >= 0) {
                    const f16x8 xv = *(const f16x8*)(RX + (size_t)(b * SEQ + ss) * DRNN + c);
                    const f32x4 w0 = *(const f32x4*)(convw + j * DRNN + c), w1 = *(const f32x4*)(convw + j * DRNN + c + 4);
#pragma unroll
                    for (int e = 0; e < 4; ++e) { xc[e] += (float)xv[e] * w0[e]; xc[4 + e] += (float)xv[4 + e] * w1[e]; }
                }
            }
            u32x4 w; w.x = pk2h(xc[0], xc[1]); w.y = pk2h(xc[2], xc[3]); w.z = pk2h(xc[4], xc[5]); w.w = pk2h(xc[6], xc[7]);
            *(LAS u32x4*)(X16 + tk * XROW + cg * 8) = w;
            *(LAS f32x4*)(LB + tk * LRU_BS + cg * 8) = (f32x4){xc[0], xc[1], xc[2], xc[3]};
            *(LAS f32x4*)(LB + tk * LRU_BS + cg * 8 + 4) = (f32x4){xc[4], xc[5], xc[6], xc[7]};
        }
        __syncthreads();
        for (int job = wave; job < 40; job += 8) {
            const int mt = job / 10, dt = job % 10;
            f32x4 zr = {0.f, 0.f, 0.f, 0.f}, zi = {0.f, 0.f, 0.f, 0.f};
#pragma unroll
            for (int ks = 0; ks < 5; ++ks) {
                const f16x8 xa = *(const LAS f16x8*)(X16 + (mt * 16 + c16) * XROW + ks * 32 + g4 * 8);
                const f16x8 wa = *(const f16x8*)(WAT + (size_t)(dt * 16 + c16) * LRU_BS + ks * 32 + g4 * 8);
                const f16x8 wx = *(const f16x8*)(WXT + (size_t)(dt * 16 + c16) * LRU_BS + ks * 32 + g4 * 8);
                zr = __builtin_amdgcn_mfma_f32_16x16x32_f16(wa, xa, zr, 0, 0, 0);
                zi = __builtin_amdgcn_mfma_f32_16x16x32_f16(wx, xa, zi, 0, 0, 0);
            }
            const int tk = mt * 16 + c16, cl = dt * 16 + g4 * 4, c = ch0 + cl;
            const f32x4 bav = *(const f32x4*)(ba + c), bxv = *(const f32x4*)(bx + c), sp = *(const f32x4*)(spl + c);
            const f32x4 xc = *(const LAS f32x4*)(LB + tk * LRU_BS + cl);
            f32x4 av, bv;
#pragma unroll
            for (int e = 0; e < 4; ++e) {
                const float r = sigmoidf_(zr[e] + bav[e]), ig = sigmoidf_(zi[e] + bxv[e]);
                const float log_a = sp[e] * r;
                av[e] = __expf(log_a);
                bv[e] = sqrtf(-expm1f(2.0f * log_a)) * (ig * xc[e]);
            }
            *(LAS f32x4*)(LA + tk * LRU_BS + cl) = av;
            *(LAS f32x4*)(LB + tk * LRU_BS + cl) = bv;
        }
        __syncthreads();
        if (tid < LRU_BS) {
            float h = hcarry;
#pragma unroll 8
            for (int tk = 0; tk < TC; ++tk) { h = LA[tk * LRU_BS + tid] * h + LB[tk * LRU_BS + tid]; LB[tk * LRU_BS + tid] = h; }
            hcarry = h;
        }
        __syncthreads();
        for (int it = tid; it < TC * (LRU_BS / 8); it += 512) {
            const int tk = it / (LRU_BS / 8), cg = it % (LRU_BS / 8);
            f16* yp = YC + (size_t)(b * SEQ + s0 + tk) * KCAT + 2048 + ch0 + cg * 8;
            const f16x8 gv = *(const f16x8*)yp;
            const f32x4 h0 = *(const LAS f32x4*)(LB + tk * LRU_BS + cg * 8), h1 = *(const LAS f32x4*)(LB + tk * LRU_BS + cg * 8 + 4);
            u32x4 w; w.x = pk2h(h0[0] * (float)gv[0], h0[1] * (float)gv[1]); w.y = pk2h(h0[2] * (float)gv[2], h0[3] * (float)gv[3]);
            w.z = pk2h(h1[0] * (float)gv[4], h1[1] * (float)gv[5]); w.w = pk2h(h1[2] * (float)gv[6], h1[3] * (float)gv[7]);
            *(u32x4*)yp = w;
        }
        __syncthreads();
    }
}
__device__ __forceinline__ void rnn_phase(Frame& F) {
    for (int it = F.vcu; it < NB * LRU_NB; it += F.G) rnn_item(F, it / LRU_NB, it % LRU_NB);
}

constexpr int KROW = 272, VROW = 320;
constexpr int AT_K = 0, AT_V = 64 * KROW;
__device__ __forceinline__ void attn_item(Frame& F, int b, int g, int qb) {
    f16* YC = WSP(f16, WS_YCAT); const f16* KB = WSP(f16, WS_K); const f16* VB = WSP(f16, WS_V); const u64* MASK = WSP(u64, WS_MASK);
    LAS unsigned char* lds = F.lds;
    const int tid = F.tid, lane = F.lane, wave = F.wave, r32 = lane & 31, hi = lane >> 5;
    const int head = g * 4 + (wave >> 1), q0 = qb * 64 + (wave & 1) * 32, tokq = b * SEQ + q0 + r32;
    f16x8 qf[8];
#pragma unroll
    for (int ks = 0; ks < 8; ++ks) qf[ks] = *(const f16x8*)(YC + (size_t)tokq * KCAT + head * 128 + ks * 16 + hi * 8);
    f32x16 o[4];
#pragma unroll
    for (int d = 0; d < 4; ++d) o[d] = (f32x16){};
    float mrun = -1e30f, lrun = 0.f;
    const int ntile = qb + 1;
    u32x4 kreg[2], vreg[2];
    auto gload = [&](int kt) {
#pragma unroll
        for (int i = 0; i < 2; ++i) { const int piece = tid + 512 * i, key = piece >> 4, ch = piece & 15; const size_t off = (size_t)(b * SEQ + kt * 64 + key) * 512 + g * 128 + ch * 8;
            kreg[i] = *(const u32x4*)(KB + off); vreg[i] = *(const u32x4*)(VB + off); }
    };
    auto swrite = [&]() {
#pragma unroll
        for (int i = 0; i < 2; ++i) { const int piece = tid + 512 * i, key = piece >> 4, ch = piece & 15;
            *(LAS u32x4*)(lds + AT_K + key * KROW + ch * 16) = kreg[i]; *(LAS u32x4*)(lds + AT_V + key * VROW + ch * 16) = vreg[i]; }
    };
    gload(0);
    for (int kt = 0; kt < ntile; ++kt) {
        __syncthreads();
        swrite();
        __syncthreads();
        if (kt + 1 < ntile) gload(kt + 1);
        const u64 mword = MASK[(size_t)tokq * 32 + kt];
        f32x16 p[2];
#pragma unroll
        for (int kb = 0; kb < 2; ++kb) {
            f32x16 acc = (f32x16){};
#pragma unroll
            for (int ks = 0; ks < 8; ++ks) {
                const f16x8 kf = *(const LAS f16x8*)(lds + AT_K + (kb * 32 + r32) * KROW + ks * 32 + hi * 16);
                acc = __builtin_amdgcn_mfma_f32_32x32x16_f16(kf, qf[ks], acc, 0, 0, 0);
            }
            p[kb] = acc;
        }
        float mx = -1e30f;
#pragma unroll
        for (int kb = 0; kb < 2; ++kb)
#pragma unroll
            for (int r = 0; r < 16; ++r) { const int kk = kb * 32 + (r & 3) + 8 * (r >> 2) + 4 * hi; const bool ok = (mword >> kk) & 1ull; p[kb][r] = ok ? p[kb][r] : -1e30f; mx = fmaxf(mx, p[kb][r]); }
        mx = fmaxf(mx, __shfl_xor(mx, 32));
        const float mnew = fmaxf(mrun, mx), alpha = fast_exp2(mrun - mnew);
        float ls = 0.f;
#pragma unroll
        for (int kb = 0; kb < 2; ++kb)
#pragma unroll
            for (int r = 0; r < 16; ++r) { const float e = (p[kb][r] > -1e29f) ? fast_exp2(p[kb][r] - mnew) : 0.f; p[kb][r] = e; ls += e; }
        ls += __shfl_xor(ls, 32);
        lrun = lrun * alpha + ls; mrun = mnew;
#pragma unroll
        for (int d = 0; d < 4; ++d)
#pragma unroll
            for (int r = 0; r < 16; ++r) o[d][r] *= alpha;
        f16x8 pf[4];
#pragma unroll
        for (int kb = 0; kb < 2; ++kb)
#pragma unroll
            for (int s = 0; s < 2; ++s) {
                u32x4 w; w.x = pk2h(p[kb][8 * s + 0], p[kb][8 * s + 1]); w.y = pk2h(p[kb][8 * s + 2], p[kb][8 * s + 3]); w.z = pk2h(p[kb][8 * s + 4], p[kb][8 * s + 5]); w.w = pk2h(p[kb][8 * s + 6], p[kb][8 * s + 7]);
                pf[kb * 2 + s] = __builtin_bit_cast(f16x8, w);
            }
        const int li = lane & 15, dgrp = (lane >> 4) & 1;
#pragma unroll
        for (int db = 0; db < 4; ++db) {
#pragma unroll
            for (int st = 0; st < 4; ++st) {
                const int key0 = 16 * st + 4 * hi;
                const LAS unsigned char* vp = lds + AT_V + (key0 + (li >> 2)) * VROW + (db * 32 + dgrp * 16 + 4 * (li & 3)) * 2;
                const s16x4 lo = __builtin_amdgcn_ds_read_tr16_b64_v4i16((LAS s16x4*)vp);
                const s16x4 hi4 = __builtin_amdgcn_ds_read_tr16_b64_v4i16((LAS s16x4*)(vp + 8 * VROW));
                typedef short s16x8 __attribute__((ext_vector_type(8)));
                const s16x8 vv = {lo[0], lo[1], lo[2], lo[3], hi4[0], hi4[1], hi4[2], hi4[3]};
                o[db] = __builtin_amdgcn_mfma_f32_32x32x16_f16(__builtin_bit_cast(f16x8, vv), pf[st], o[db], 0, 0, 0);
            }
        }
    }
    const float inv = fast_rcp(lrun);
#pragma unroll
    for (int db = 0; db < 4; ++db)
#pragma unroll
        for (int r4 = 0; r4 < 4; ++r4) {
            u32x2 w; w.x = pk2h(o[db][4 * r4 + 0] * inv, o[db][4 * r4 + 1] * inv); w.y = pk2h(o[db][4 * r4 + 2] * inv, o[db][4 * r4 + 3] * inv);
            *(u32x2*)(YC + (size_t)tokq * KCAT + head * 128 + db * 32 + 8 * r4 + 4 * hi) = w;
        }
    __syncthreads();
}
__device__ __forceinline__ void attn_phase(Frame& F) {
    for (int rep = 0; rep < 2; ++rep)
        for (int vv = F.vcu; vv < 256; vv += F.G) {
            const int b = vv >> 6, w = vv & 63, g = w >> 4, j = w & 15;
            attn_item(F, b, g, rep == 0 ? j : 31 - j);
        }
}

__global__ void __launch_bounds__(512, 2) mk_fwd(Args args) {
    extern __shared__ __attribute__((aligned(16))) unsigned char lds_raw[];
    Frame F;
    F.lds = (LAS unsigned char*)lds_raw;
    F.tid = threadIdx.x; F.lane = F.tid & 63; F.wave = __builtin_amdgcn_readfirstlane(F.tid >> 6);
    F.G = gridDim.x; { const int bx = blockIdx.x; F.vcu = (F.G % 8 == 0) ? (bx % 8) * (F.G / 8) + bx / 8 : bx; }
    F.a = &args; F.ws = args.ws;
    const int lo = args.ph_lo, hi = args.ph_hi;
    volatile LAS unsigned* MISC = (volatile LAS unsigned*)(F.lds + LDSCTL_OFF);
    if (F.tid < 32) MISC[F.tid] = 0u;
    __syncthreads();
    XcdBarrier bar; bar.bar = (unsigned*)(F.ws + WS_CTL) + 4096; bar.x = 0; bar.st = nullptr;
    if (hi - lo > 1) bar = xcd_barrier_post((unsigned*)(F.ws + WS_CTL) + 4096, MISC + 8);
#define IN(k) (lo <= (k) && (k) < hi)
#define SEAM(k) do { if (IN(k) && IN((k) + 1)) xcd_barrier(bar); } while (0)
    const Args& A = args;
    pg8::StaticOrder S;
    if (IN(0)) { p0_prologue(F); } SEAM(0);
    if (IN(1)) {
        pg8::Gemm g{WSP(f16, WS_HB), WSP(f16, WS_W1IN), T, 2 * DFF, D}; S.init(T, 2 * DFF, F.G, (int)blockIdx.x);
        EpiSwiglu E{WSP(f16, WS_ACT)};
        pg8::gemm_phase<EpiSwiglu, 0>(F.lds, g, S, E);
    } SEAM(1);
    if (IN(2)) {
        pg8::Gemm g{WSP(f16, WS_ACT), WSP(f16, WS_W1OUT), T, D, DFF}; S.init(T, D, F.G, (int)blockIdx.x);
        EpiResid<true> E{(const void*)A.in[0], WSP(float, WS_R), DN_ALPHA, 0.5f};
        pg8::gemm_phase<EpiResid<true>, 0>(F.lds, g, S, E);
    } SEAM(2);
    if (IN(3)) { ln_phase(F, WSP(float, WS_R), A.in[4], A.in[5], WSP(f16, WS_HB), nullptr); } SEAM(3);
    if (IN(4)) {
        pg8::Gemm g{WSP(f16, WS_HB), WSP(f16, WS_WIN), T, NINP, D}; S.init(T, NINP, F.G, (int)blockIdx.x);
        EpiMixer E{WSP(f16, WS_YCAT), WSP(f16, WS_K), WSP(f16, WS_V), WSP(f16, WS_RX), WSP(f16, WS_GATES), WSP(f16, WS_QI), WSP(f16, WS_KI), WSP(float, WS_WI),
                   (const float*)(F.ws + WS_TAB + TAB_COSQ), (const float*)(F.ws + WS_TAB + TAB_SINQ), (const float*)(F.ws + WS_TAB + TAB_COSI), (const float*)(F.ws + WS_TAB + TAB_SINI)};
        pg8::gemm_phase<EpiMixer, 0>(F.lds, g, S, E);
    } SEAM(4);
    if (IN(5)) { indexer_phase(F); rnn_phase(F); } SEAM(5);
    if (IN(6)) { attn_phase(F); } SEAM(6);
    if (IN(7)) {
        pg8::Gemm g{WSP(f16, WS_YCAT), WSP(f16, WS_WCAT), T, D, KCAT}; S.init(T, D, F.G, (int)blockIdx.x);
        EpiMerged E{WSP(f16, WS_GATES), WSP(f16, WS_MERGED)};
        pg8::gemm_phase<EpiMerged, 32>(F.lds, g, S, E);
    } SEAM(7);
    if (IN(8)) {
        pg8::Gemm g{WSP(f16, WS_MERGED), WSP(f16, WS_WOUT), T, D, D}; S.init(T, D, F.G, (int)blockIdx.x);
        EpiResid<false> E{(const void*)WSP(f16, WS_HB), WSP(float, WS_R), DN_ALPHA, 1.0f};
        pg8::gemm_phase<EpiResid<false>, 0>(F.lds, g, S, E);
    } SEAM(8);
    if (IN(9)) { ln_phase(F, WSP(float, WS_R), A.in[17], A.in[18], WSP(f16, WS_HB), nullptr); convert_ffn(F, A.in[19], A.in[20], WSP(f16, WS_W1IN), WSP(f16, WS_W1OUT)); } SEAM(9);
    if (IN(10)) {
        pg8::Gemm g{WSP(f16, WS_HB), WSP(f16, WS_W1IN), T, 2 * DFF, D}; S.init(T, 2 * DFF, F.G, (int)blockIdx.x);
        EpiSwiglu E{WSP(f16, WS_ACT)};
        pg8::gemm_phase<EpiSwiglu, 0>(F.lds, g, S, E);
    } SEAM(10);
    if (IN(11)) {
        pg8::Gemm g{WSP(f16, WS_ACT), WSP(f16, WS_W1OUT), T, D, DFF}; S.init(T, D, F.G, (int)blockIdx.x);
        EpiResid<false> E{(const void*)WSP(f16, WS_HB), WSP(float, WS_R), DN_ALPHA, 0.5f};
        pg8::gemm_phase<EpiResid<false>, 0>(F.lds, g, S, E);
    } SEAM(11);
    if (IN(12)) { ln_phase(F, WSP(float, WS_R), A.in[21], A.in[22], nullptr, args.out); }
#undef IN
#undef SEAM
}

extern "C" void kernel_launch(void* const* d_in, const int* in_sizes, int n_in, void* d_out, int out_size, void* d_ws, size_t ws_size, hipStream_t stream) {
    static int grid = 0;
    if (grid == 0) {
        if (n_in != 23 || in_sizes[0] != T * D || out_size != T * D || ws_size < WS_END) { fprintf(stderr, "kernel_launch: unexpected shapes (n_in %d, in0 %d, out %d, ws %zu)\n", n_in, n_in > 0 ? in_sizes[0] : -1, out_size, ws_size); grid = -1; return; }
        int dev = 0, cus = 0, per_cu = 0;
        if (hipGetDevice(&dev) != hipSuccess || hipDeviceGetAttribute(&cus, hipDeviceAttributeMultiprocessorCount, dev) != hipSuccess) { grid = -1; return; }
        if (hipFuncSetAttribute((const void*)mk_fwd, hipFuncAttributeMaxDynamicSharedMemorySize, LDS_BYTES) != hipSuccess) { fprintf(stderr, "kernel_launch: hipFuncSetAttribute failed\n"); grid = -1; return; }
        if (hipOccupancyMaxActiveBlocksPerMultiprocessor(&per_cu, (const void*)mk_fwd, 512, LDS_BYTES) != hipSuccess || per_cu < 1) { fprintf(stderr, "kernel_launch: occupancy query reports %d\n", per_cu); per_cu = 1; }
        (void)hipGetLastError();
        grid = cus * 1;
        if (grid > 256) grid = 256;
    }
    if (grid < 0) return;
    (void)hipMemsetAsync((char*)d_ws + WS_CTL, 0, CTL_BYTES, stream);
    Args a{};
    for (int i = 0; i < 23; ++i) a.in[i] = (const float*)d_in[i];
    a.out = (float*)d_out; a.ws = (unsigned char*)d_ws;
    if (MK_LAUNCHES == 1) {
        a.ph_lo = 0; a.ph_hi = NPHASE;
        hipLaunchKernelGGL(mk_fwd, dim3(grid), dim3(512), LDS_BYTES, stream, a);
    } else {
        for (int p = 0; p < NPHASE; ++p) { a.ph_lo = p; a.ph_hi = p + 1; hipLaunchKernelGGL(mk_fwd, dim3(grid), dim3(512), LDS_BYTES, stream, a); }
    }
}
```

```cpp
#include <hip/hip_runtime.h>
#include <cstdio>
#include <cstdint>

#define LAS __attribute__((address_space(3)))
#define GAS __attribute__((address_space(1)))
typedef _Float16 f16;
typedef _Float16 f16x8 __attribute__((ext_vector_type(8)));
typedef _Float16 f16x4 __attribute__((ext_vector_type(4)));
typedef _Float16 f16x2 __attribute__((ext_vector_type(2)));
typedef short s16x4 __attribute__((ext_vector_type(4)));
typedef float f32x4 __attribute__((ext_vector_type(4)));
typedef float f32x2 __attribute__((ext_vector_type(2)));
typedef float f32x16 __attribute__((ext_vector_type(16)));
typedef unsigned u32x4 __attribute__((ext_vector_type(4)));
typedef unsigned u32x2 __attribute__((ext_vector_type(2)));
typedef unsigned long long u64;

#ifndef MK_LAUNCHES
#define MK_LAUNCHES 1
#endif

constexpr int NB = 4, SEQ = 2048, T = NB * SEQ, D = 2048, DFF = 5632, NIN = 13392, NINP = 13568, DRNN = 2560, KCAT = 4608;
constexpr int NH = 16, NKV = 4, HD = 128, NIH = 16, IDD = 64, TOPK = 256;
constexpr int LRU_NB = 16, LRU_BS = 160;
constexpr float LN_EPS = 1e-5f;
constexpr float DN_ALPHA = 1.189207115002721f;
constexpr float QSCALE = 0.08838834764831845f * 1.4426950408889634f;
constexpr int NPHASE = 13;

constexpr size_t MiB = 1u << 20;
constexpr size_t WS_CTL = 0, CTL_BYTES = 1 * MiB;
constexpr size_t WS_TAB = 1 * MiB;
constexpr size_t TAB_COSQ = 0, TAB_SINQ = 512 * 1024, TAB_COSI = 1024 * 1024, TAB_SINI = 1280 * 1024, TAB_SPL = 1536 * 1024;
constexpr size_t WS_WAT = 3 * MiB, WS_WXT = 4 * MiB;
constexpr size_t WS_W1IN = 5 * MiB, WS_W1OUT = 49 * MiB;
constexpr size_t WS_MERGED = 5 * MiB;
constexpr size_t WS_WIN = 71 * MiB, WS_WCAT = 124 * MiB, WS_WOUT = 142 * MiB;
constexpr size_t WS_HB = 150 * MiB;
constexpr size_t WS_ACT = 182 * MiB;
constexpr size_t WS_GATES = 182 * MiB, WS_QI = 246 * MiB, WS_KI = 262 * MiB, WS_WI = 263 * MiB, WS_MASK = 264 * MiB;
constexpr size_t WS_R = 270 * MiB;
constexpr size_t WS_RX = 270 * MiB, WS_K = 310 * MiB, WS_V = 318 * MiB;
constexpr size_t WS_YCAT = 334 * MiB;
constexpr size_t WS_END = 406 * MiB;

constexpr int RING_BYTES = 131072;
constexpr int LDSCTL_OFF = 131072 + 8192;
constexpr int LDS_BYTES = 147456;

__device__ __forceinline__ unsigned pk2h(float lo, float hi) { f32x2 v = {lo, hi}; f16x2 h = __builtin_convertvector(v, f16x2); return __builtin_bit_cast(unsigned, h); }
__device__ __forceinline__ f32x4 h4_to_f4(u32x2 w) { f16x4 h = __builtin_bit_cast(f16x4, w); return __builtin_convertvector(h, f32x4); }
__device__ __forceinline__ float fast_rcp(float x) { return __builtin_amdgcn_rcpf(x); }
__device__ __forceinline__ float fast_exp2(float x) { return __builtin_amdgcn_exp2f(x); }
__device__ __forceinline__ float sigmoidf_(float x) { return fast_rcp(1.0f + fast_exp2(-1.4426950408889634f * x)); }
__device__ __forceinline__ float siluf_(float x) { return x * sigmoidf_(x); }
__device__ __forceinline__ float gelu_tanh_(float x) {
    const float u = 0.7978845608028654f * (x + 0.044715f * x * x * x);
    return x * sigmoidf_(2.0f * u);
}
#define VM_WAIT() asm volatile("s_waitcnt vmcnt(0)" ::: "memory")
#define LDS_WAIT() asm volatile("s_waitcnt lgkmcnt(0)" ::: "memory")

namespace pg8 {
constexpr int BM = 256, BK = 64, HALF = 128, HTB = HALF * BK * 2, STAGE_BYTES = 8 * HTB, NXCD = 8, WGM = 8;
__host__ __device__ __forceinline__ int lds_byte(int r, int c) { const int st = (r >> 4) * 2 + (c >> 5), rr = r & 15, cc = c & 31, ob = rr * 64 + cc * 2; return st * 1024 + (ob ^ (((ob >> 9) & 1) << 5)); }
__host__ __device__ __forceinline__ void stage_rc(int b, int& R, int& C) { const int st = b / 1024, sb = b % 1024, swz = sb ^ (((sb >> 9) & 1) << 5); R = (st >> 1) * 16 + swz / 64; C = (st & 1) * 32 + (swz % 64) / 2; }
struct Unit { int pm, pn; };
struct Gemm { const f16* A; const f16* Bt; int M, N, K; };
struct StaticOrder {
    int nM, nN, nwg, G, c;
    __host__ __device__ void init(int M, int N, int G_, int c_) { nM = M / BM; nN = N / BM; nwg = nM * nN; G = G_; c = c_; }
    __host__ __device__ bool next(int i, Unit& u) const {
        const long L = (long)i * G + c; if (L >= nwg) return false;
        int wgid = (int)L; { const int q = nwg / NXCD, r = nwg % NXCD, xcd = wgid % NXCD, off = wgid / NXCD; wgid = (xcd < r ? xcd * (q + 1) : r * (q + 1) + (xcd - r) * q) + off; }
        const int nig = WGM * nN, gid = wgid / nig, fm = gid * WGM, gsz = (nM - fm) < WGM ? (nM - fm) : WGM;
        u.pm = fm + ((wgid % nig) % gsz); u.pn = (wgid % nig) / gsz; return true;
    }
};
template <class Epi, int MIDT>
__device__ __forceinline__ void gemm_phase(LAS unsigned char* lds, const Gemm g, const StaticOrder& S, const Epi& E) {
    const int tid = threadIdx.x, wid = __builtin_amdgcn_readfirstlane(tid >> 6), lane = tid & 63, wr = wid >> 2, wc = wid & 3, fr = lane & 15, fq = lane >> 4;
    const int K = g.K, nt = K / BK;
    unsigned voffA[2];
#pragma unroll
    for (int i = 0; i < 2; ++i) { int R, C; stage_rc(tid * 16 + i * 8192, R, C); voffA[i] = (unsigned)(R * K + C) * 2u; }
    const size_t kstep = (size_t)(BK * 2);
    const size_t hstep = (size_t)HALF * K * 2;
    const size_t tstep = 2 * hstep;
    const unsigned ldsw = (unsigned)wid * 1024u;
    const int aoff = lds_byte(wr * 64 + fr, fq * 8), boff = lds_byte(wc * 32 + fr, fq * 8);
#define PG8_SA(b, h) (((b) * 2 + (h)) * HTB)
#define PG8_SB(b, h) ((4 + (b) * 2 + (h)) * HTB)
#define PG8_STAGE(bufoff, gbase) do { _Pragma("unroll") for (int _i = 0; _i < 2; ++_i) \
        __builtin_amdgcn_global_load_lds((const unsigned*)((const char*)(gbase) + voffA[_i]), (LAS unsigned*)(lds + (bufoff) + ldsw + _i * 8192), 16, 0, 0); } while (0)
#define PG8_LDA(dst, b, h) do { _Pragma("unroll") for (int m = 0; m < 4; ++m) _Pragma("unroll") for (int k = 0; k < 2; ++k) dst[m][k] = *(const LAS f16x8*)(lds + PG8_SA(b, h) + aoff + m * 2048 + k * 1024); } while (0)
#define PG8_LDB(dst, b, h) do { _Pragma("unroll") for (int n = 0; n < 2; ++n) _Pragma("unroll") for (int k = 0; k < 2; ++k) dst[n][k] = *(const LAS f16x8*)(lds + PG8_SB(b, h) + boff + n * 2048 + k * 1024); } while (0)
#define PG8_MMA(ai, bj, At, Bt) do { __builtin_amdgcn_s_setprio(1); _Pragma("unroll") for (int m = 0; m < 4; ++m) _Pragma("unroll") for (int n = 0; n < 2; ++n) _Pragma("unroll") for (int k = 0; k < 2; ++k) \
        acc[ai][bj][m][n] = __builtin_amdgcn_mfma_f32_16x16x32_f16(Bt[n][k], At[m][k], acc[ai][bj][m][n], 0, 0, 0); __builtin_amdgcn_s_setprio(0); } while (0)
#define PG8_WAIT_V(n) asm volatile("s_waitcnt vmcnt(" #n ")" ::: "memory")
#define PG8_WAIT_L(n) asm volatile("s_waitcnt lgkmcnt(" #n ")" ::: "memory")
#define PG8_BAR __builtin_amdgcn_s_barrier()
#define PG8_SCHED __builtin_amdgcn_sched_barrier(0)
    Unit cur, nxt; int ui = 0;
    if (!S.next(0, cur)) return;
    f32x4 acc[2][2][4][2];
#pragma unroll
    for (int a = 0; a < 2; ++a)
#pragma unroll
        for (int b = 0; b < 2; ++b)
#pragma unroll
            for (int m = 0; m < 4; ++m)
#pragma unroll
                for (int n = 0; n < 2; ++n) acc[a][b][m][n] = (f32x4){0.f, 0.f, 0.f, 0.f};
    f16x8 At[4][2], B0[2][2], B1[2][2];
    const char* cA = (const char*)g.A + (size_t)cur.pm * tstep; const char* cB = (const char*)g.Bt + (size_t)cur.pn * tstep;
    PG8_STAGE(PG8_SB(0, 0), cB); PG8_STAGE(PG8_SB(0, 1), cB + hstep); PG8_STAGE(PG8_SA(0, 0), cA); PG8_STAGE(PG8_SA(0, 1), cA + hstep);
    if (wr == 1) PG8_BAR;
    PG8_WAIT_V(2); PG8_BAR;
    PG8_STAGE(PG8_SB(1, 0), cB + kstep); PG8_STAGE(PG8_SA(1, 0), cA + kstep); PG8_STAGE(PG8_SB(1, 1), cB + hstep + kstep);
    PG8_WAIT_V(6); PG8_BAR;
    for (;;) {
        const bool has_next = S.next(ui + 1, nxt);
        const char* nA = has_next ? (const char*)g.A + (size_t)nxt.pm * tstep : cA; const char* nB = has_next ? (const char*)g.Bt + (size_t)nxt.pn * tstep : cB;
        for (int t = 0; t < nt; t += 2) {
            const bool last = (t == nt - 2);
            const char* a1 = cA + (size_t)(t + 1) * kstep;
            const char* a2 = last ? nA : cA + (size_t)(t + 2) * kstep; const char* b2 = last ? nB : cB + (size_t)(t + 2) * kstep;
            const char* a3 = a2 + kstep; const char* b3 = b2 + kstep;
            if constexpr (MIDT > 0) { if (t == MIDT) E.mid(acc, cur, wr, wc, fr, fq); }
            PG8_LDB(B0, 0, 0); PG8_LDB(B1, 0, 1); PG8_SCHED; PG8_LDA(At, 0, 0); PG8_STAGE(PG8_SA(1, 1), a1 + hstep);
            PG8_WAIT_V(8); PG8_WAIT_L(0); PG8_BAR; PG8_MMA(0, 0, At, B0); PG8_MMA(0, 1, At, B1); PG8_BAR; PG8_SCHED;
            PG8_LDA(At, 0, 1); PG8_STAGE(PG8_SB(0, 0), b2); PG8_STAGE(PG8_SB(0, 1), b2 + hstep); PG8_STAGE(PG8_SA(0, 0), a2);
            PG8_WAIT_V(8); PG8_WAIT_L(0); PG8_BAR; PG8_MMA(1, 0, At, B0); PG8_MMA(1, 1, At, B1); PG8_BAR; PG8_SCHED;
            PG8_LDB(B0, 1, 0); PG8_LDB(B1, 1, 1); PG8_SCHED; PG8_LDA(At, 1, 0); PG8_STAGE(PG8_SA(0, 1), a2 + hstep);
            PG8_WAIT_V(8); PG8_WAIT_L(0); PG8_BAR; PG8_MMA(0, 0, At, B0); PG8_MMA(0, 1, At, B1); PG8_BAR; PG8_SCHED;
            PG8_LDA(At, 1, 1); PG8_STAGE(PG8_SB(1, 0), b3); PG8_STAGE(PG8_SB(1, 1), b3 + hstep); PG8_STAGE(PG8_SA(1, 0), a3);
            PG8_WAIT_V(8); PG8_WAIT_L(0); PG8_BAR; PG8_MMA(1, 0, At, B0); PG8_MMA(1, 1, At, B1); PG8_BAR; PG8_SCHED;
        }
        if (wr == 0) PG8_BAR;
        E(acc, cur, wr, wc, fr, fq);
        if (!has_next) break;
#pragma unroll
        for (int a = 0; a < 2; ++a)
#pragma unroll
            for (int b = 0; b < 2; ++b)
#pragma unroll
                for (int m = 0; m < 4; ++m)
#pragma unroll
                    for (int n = 0; n < 2; ++n) acc[a][b][m][n] = (f32x4){0.f, 0.f, 0.f, 0.f};
        cur = nxt; cA = nA; cB = nB; ++ui;
        if (wr == 1) PG8_BAR;
    }
    PG8_WAIT_V(0);
    PG8_BAR;
#undef PG8_SA
#undef PG8_SB
#undef PG8_STAGE
#undef PG8_LDA
#undef PG8_LDB
#undef PG8_MMA
#undef PG8_WAIT_V
#undef PG8_WAIT_L
#undef PG8_BAR
#undef PG8_SCHED
}
}
using pg8::Unit;
typedef const f32x4 (&AccRef)[2][2][4][2];

struct EpiSwiglu {
    f16* O;
    __device__ __forceinline__ void operator()(AccRef acc, const Unit& u, int wr, int wc, int fr, int fq) const {
        const int row0 = u.pm * 256 + wr * 64 + fr, col0 = u.pn * 128 + wc * 32 + 8 * fq;
#pragma unroll
        for (int ai = 0; ai < 2; ++ai)
#pragma unroll
            for (int m = 0; m < 4; ++m) {
                const f32x4 a0 = acc[ai][0][m][0], a1 = acc[ai][0][m][1], b0 = acc[ai][1][m][0], b1 = acc[ai][1][m][1];
                u32x4 w;
                w.x = pk2h(siluf_(a0[0]) * b0[0], siluf_(a0[1]) * b0[1]); w.y = pk2h(siluf_(a0[2]) * b0[2], siluf_(a0[3]) * b0[3]);
                w.z = pk2h(siluf_(a1[0]) * b1[0], siluf_(a1[1]) * b1[1]); w.w = pk2h(siluf_(a1[2]) * b1[2], siluf_(a1[3]) * b1[3]);
                *(u32x4*)(O + (size_t)(row0 + ai * 128 + m * 16) * DFF + col0) = w;
            }
    }
};
template <bool RESF32> struct EpiResid {
    const void* res; float* R; float alpha, beta;
    __device__ __forceinline__ void operator()(AccRef acc, const Unit& u, int wr, int wc, int fr, int fq) const {
        const int row0 = u.pm * 256 + wr * 64 + fr, col0 = u.pn * 256 + wc * 32 + 4 * fq;
#pragma unroll
        for (int ai = 0; ai < 2; ++ai)
#pragma unroll
            for (int m = 0; m < 4; ++m) {
                const size_t off = (size_t)(row0 + ai * 128 + m * 16) * D + col0;
#pragma unroll
                for (int bj = 0; bj < 2; ++bj)
#pragma unroll
                    for (int n = 0; n < 2; ++n) {
                        f32x4 rv;
                        if (RESF32) rv = *(const f32x4*)((const float*)res + off + bj * 128 + n * 16);
                        else rv = h4_to_f4(*(const u32x2*)((const f16*)res + off + bj * 128 + n * 16));
                        *(f32x4*)(R + off + bj * 128 + n * 16) = rv * alpha + acc[ai][bj][m][n] * beta;
                    }
            }
    }
};
struct EpiMixer {
    f16 *YCAT, *KB, *VB, *RX, *GATES, *QI, *KI; float* WI;
    const float *cosq, *sinq, *cosi, *sini;
    __device__ __forceinline__ void operator()(AccRef acc, const Unit& u, int wr, int wc, int fr, int fq) const {
        const int row0 = u.pm * 256 + wr * 64 + fr, pn = u.pn;
        if (pn < 10) {
            const int cn = wc * 32 + 4 * fq;
            const float sc = pn < 8 ? QSCALE : 1.0f;
#pragma unroll
            for (int ai = 0; ai < 2; ++ai)
#pragma unroll
                for (int m = 0; m < 4; ++m) {
                    const int row = row0 + ai * 128 + m * 16;
                    f32x4 cs = {1.f, 1.f, 1.f, 1.f}, sn = {0.f, 0.f, 0.f, 0.f};
                    if (wc == 0) { cs = *(const f32x4*)(cosq + (size_t)row * 16 + 4 * fq); sn = *(const f32x4*)(sinq + (size_t)row * 16 + 4 * fq); }
#pragma unroll
                    for (int bj = 0; bj < 2; ++bj) {
                        f32x4 v0 = acc[ai][bj][m][0], v1 = acc[ai][bj][m][1];
                        if (wc == 0) { const f32x4 t0 = v0 * cs - v1 * sn, t1 = v1 * cs + v0 * sn; v0 = t0; v1 = t1; }
                        v0 = v0 * sc; v1 = v1 * sc;
                        u32x2 w0, w1; w0.x = pk2h(v0[0], v0[1]); w0.y = pk2h(v0[2], v0[3]); w1.x = pk2h(v1[0], v1[1]); w1.y = pk2h(v1[2], v1[3]);
                        f16* p = pn < 8 ? YCAT + (size_t)row * KCAT + pn * 256 + bj * 128 + cn : KB + (size_t)row * 512 + (pn - 8) * 256 + bj * 128 + cn;
                        *(u32x2*)p = w0; *(u32x2*)(p + 16) = w1;
                    }
                }
        } else if (pn < 48) {
            const int cn = wc * 32 + 8 * fq;
            f16* base; int ldc, act;
            if (pn < 12) { base = VB + (pn - 10) * 256; ldc = 512; act = 0; }
            else if (pn < 22) { base = RX + (pn - 12) * 256; ldc = DRNN; act = 0; }
            else if (pn < 32) { base = YCAT + 2048 + (pn - 22) * 256; ldc = KCAT; act = 1; }
            else { base = GATES + (pn - 32) * 256; ldc = 4096; act = 2; }
#pragma unroll
            for (int ai = 0; ai < 2; ++ai)
#pragma unroll
                for (int m = 0; m < 4; ++m) {
                    const int row = row0 + ai * 128 + m * 16;
#pragma unroll
                    for (int bj = 0; bj < 2; ++bj) {
                        f32x4 v0 = acc[ai][bj][m][0], v1 = acc[ai][bj][m][1];
                        if (act == 1) {
#pragma unroll
                            for (int e = 0; e < 4; ++e) { v0[e] = gelu_tanh_(v0[e]); v1[e] = gelu_tanh_(v1[e]); }
                        } else if (act == 2) {
#pragma unroll
                            for (int e = 0; e < 4; ++e) { v0[e] = sigmoidf_(v0[e]); v1[e] = sigmoidf_(v1[e]); }
                        }
                        u32x4 w; w.x = pk2h(v0[0], v0[1]); w.y = pk2h(v0[2], v0[3]); w.z = pk2h(v1[0], v1[1]); w.w = pk2h(v1[2], v1[3]);
                        *(u32x4*)(base + (size_t)row * ldc + bj * 128 + cn) = w;
                    }
                }
        } else {
            const int cn = wc * 32 + 4 * fq;
            const bool rot = ((wc & 1) == 0) && (fq < 2);
#pragma unroll
            for (int ai = 0; ai < 2; ++ai)
#pragma unroll
                for (int m = 0; m < 4; ++m) {
                    const int row = row0 + ai * 128 + m * 16;
                    f32x4 cs = {1.f, 1.f, 1.f, 1.f}, sn = {0.f, 0.f, 0.f, 0.f};
                    if (rot) { cs = *(const f32x4*)(cosi + (size_t)row * 8 + 4 * fq); sn = *(const f32x4*)(sini + (size_t)row * 8 + 4 * fq); }
#pragma unroll
                    for (int bj = 0; bj < 2; ++bj) {
                        f32x4 v0 = acc[ai][bj][m][0], v1 = acc[ai][bj][m][1];
                        if (pn < 52) {
                            if (rot) { const f32x4 t0 = v0 * cs - v1 * sn, t1 = v1 * cs + v0 * sn; v0 = t0; v1 = t1; }
                            u32x2 w0, w1; w0.x = pk2h(v0[0], v0[1]); w0.y = pk2h(v0[2], v0[3]); w1.x = pk2h(v1[0], v1[1]); w1.y = pk2h(v1[2], v1[3]);
                            f16* p = QI + (size_t)row * 1024 + (pn - 48) * 256 + bj * 128 + cn;
                            *(u32x2*)p = w0; *(u32x2*)(p + 16) = w1;
                        } else if (bj == 0) {
                            if (wc < 2) {
                                if (rot) { const f32x4 t0 = v0 * cs - v1 * sn, t1 = v1 * cs + v0 * sn; v0 = t0; v1 = t1; }
                                u32x2 w0, w1; w0.x = pk2h(v0[0], v0[1]); w0.y = pk2h(v0[2], v0[3]); w1.x = pk2h(v1[0], v1[1]); w1.y = pk2h(v1[2], v1[3]);
                                f16* p = KI + (size_t)row * 64 + cn;
                                *(u32x2*)p = w0; *(u32x2*)(p + 16) = w1;
                            } else if (wc == 2) {
                                *(f32x4*)(WI + (size_t)row * 16 + 4 * fq) = v0 * 0.03125f;
                            }
                        }
                    }
                }
        }
    }
};
struct EpiMerged {
    const f16* GATES; f16* O;
    __device__ __forceinline__ void mid(f32x4 (&acc)[2][2][4][2], const Unit& u, int wr, int wc, int fr, int fq) const {
        int row0 = u.pm * 256 + wr * 64 + fr, col0 = u.pn * 256 + wc * 32 + 8 * fq;
        asm volatile("" : "+v"(row0), "+v"(col0));
#pragma unroll
        for (int ai = 0; ai < 2; ++ai)
#pragma unroll
            for (int m = 0; m < 4; ++m) {
                const f16* gp = GATES + (size_t)(row0 + ai * 128 + m * 16) * 4096 + col0;
#pragma unroll
                for (int bj = 0; bj < 2; ++bj) {
                    const u32x4 ga = *(const u32x4*)(gp + bj * 128), gr = *(const u32x4*)(gp + 2048 + bj * 128);
                    const f32x4 ga0 = h4_to_f4((u32x2){ga.x, ga.y}), ga1 = h4_to_f4((u32x2){ga.z, ga.w}), gr0 = h4_to_f4((u32x2){gr.x, gr.y}), gr1 = h4_to_f4((u32x2){gr.z, gr.w});
#pragma unroll
                    for (int e = 0; e < 4; ++e) { acc[ai][bj][m][0][e] *= ga0[e] * fast_rcp(gr0[e]); acc[ai][bj][m][1][e] *= ga1[e] * fast_rcp(gr1[e]); }
                }
                asm volatile("" : "+v"(acc[ai][0][m][0]), "+v"(acc[ai][0][m][1]), "+v"(acc[ai][1][m][0]), "+v"(acc[ai][1][m][1]) :: "memory");
            }
    }
    __device__ __forceinline__ void operator()(AccRef acc, const Unit& u, int wr, int wc, int fr, int fq) const {
        const int row0 = u.pm * 256 + wr * 64 + fr, col0 = u.pn * 256 + wc * 32 + 8 * fq;
#pragma unroll
        for (int ai = 0; ai < 2; ++ai)
#pragma unroll
            for (int m = 0; m < 4; ++m) {
                const size_t row = (size_t)(row0 + ai * 128 + m * 16);
#pragma unroll
                for (int bj = 0; bj < 2; ++bj) {
                    const u32x4 gr = *(const u32x4*)(GATES + row * 4096 + 2048 + col0 + bj * 128);
                    const f32x4 gr0 = h4_to_f4((u32x2){gr.x, gr.y}), gr1 = h4_to_f4((u32x2){gr.z, gr.w});
                    const f32x4 v0 = acc[ai][bj][m][0] * gr0, v1 = acc[ai][bj][m][1] * gr1;
                    u32x4 w; w.x = pk2h(v0[0], v0[1]); w.y = pk2h(v0[2], v0[3]); w.z = pk2h(v1[0], v1[1]); w.w = pk2h(v1[2], v1[3]);
                    *(u32x4*)(O + row * D + col0 + bj * 128) = w;
                }
            }
    }
};

#define XB_TMO      128
#define XB_XCNT(j)  (256  + 64 * (j))
#define XB_XSUB(j)  (1280 + 64 * (j))
#define XB_XGEN(j)  (2304 + 64 * (j))
#define XB_TOP      3328
#define XB_TOPGEN   3392
#define XCD_BAR_WORDS 3456
#define XB_SPIN_CAP (1u << 22)
__device__ __forceinline__ unsigned xb_ld(unsigned* p)              { return __hip_atomic_load(p, __ATOMIC_RELAXED, __HIP_MEMORY_SCOPE_AGENT); }
__device__ __forceinline__ unsigned xb_add(unsigned* p, unsigned v) { return __hip_atomic_fetch_add(p, v, __ATOMIC_RELAXED, __HIP_MEMORY_SCOPE_AGENT); }
__device__ __forceinline__ unsigned xb_xcc_id() { return (unsigned)__builtin_amdgcn_s_getreg((3 << 11) | 20) & 0xFu; }
#define XB_SPIN(cond, bar) do { unsigned _sp = 0; while (cond) { __builtin_amdgcn_s_sleep(1); \
    if ((++_sp & 255u) == 0u) { if (xb_ld(&(bar)[XB_TMO])) break; if (_sp > XB_SPIN_CAP) { atomicAdd(&(bar)[XB_TMO], 1u); break; } } } } while (0)
struct XcdBarrier { unsigned* bar; unsigned x; volatile LAS unsigned* st; };
__device__ __forceinline__ XcdBarrier xcd_barrier_post(unsigned* bar, volatile LAS unsigned* st) {
    XcdBarrier b; b.bar = bar; b.x = xb_xcc_id(); b.st = st;
    if (threadIdx.x == 0) (void)xb_add(&bar[XB_XCNT(b.x)], 1u);
    return b;
}
__device__ __forceinline__ void xcd_barrier_complete(unsigned* bar, unsigned x, unsigned& nloc, unsigned& nx) {
    const unsigned G = gridDim.x * gridDim.y * gridDim.z;
    unsigned sum, cnt, mine, sp = 0u;
    for (;;) {
        sum = 0u; cnt = 0u; mine = 0u;
#pragma unroll
        for (unsigned j = 0; j < 16; ++j) { const unsigned c = xb_ld(&bar[XB_XCNT(j)]); sum += c; cnt += (c > 0u) ? 1u : 0u; mine = (j == x) ? c : mine; }
        if (sum == G) break;
        __builtin_amdgcn_s_sleep(1);
        if ((++sp & 255u) == 0u) { if (xb_ld(&bar[XB_TMO])) break; if (sp > XB_SPIN_CAP) { atomicAdd(&bar[XB_TMO], 1u); break; } }
    }
    nloc = mine > 0u ? mine : 1u; nx = cnt > 0u ? cnt : 1u;
}
__device__ __forceinline__ void xcd_barrier(const XcdBarrier& b) {
    asm volatile("s_waitcnt vmcnt(0)" ::: "memory");
    __syncthreads();
    if (threadIdx.x == 0) {
        unsigned* bar = b.bar;
        __builtin_amdgcn_s_waitcnt(0);
        unsigned nloc = b.st[0], nx = b.st[1];
        if (nloc == 0u) { xcd_barrier_complete(bar, b.x, nloc, nx); b.st[0] = nloc; b.st[1] = nx; }
        const unsigned old = xb_add(&bar[XB_XSUB(b.x)], 1u);
        const unsigned gen = old / nloc;
        if (old + 1u == (gen + 1u) * nloc) {
            __builtin_amdgcn_fence(__ATOMIC_RELEASE, "agent");
            asm volatile("s_waitcnt vmcnt(0)" ::: "memory");
            const unsigned og = xb_add(&bar[XB_TOP], 1u);
            const unsigned tg = og / nx;
            if (og + 1u == (tg + 1u) * nx) xb_add(&bar[XB_TOPGEN], 1u);
            else XB_SPIN(xb_ld(&bar[XB_TOPGEN]) == tg, bar);
            __builtin_amdgcn_fence(__ATOMIC_ACQUIRE, "agent");
            xb_add(&bar[XB_XGEN(b.x)], 1u);
            asm volatile("s_waitcnt vmcnt(0)" ::: "memory");
        } else {
            XB_SPIN(xb_ld(&bar[XB_XGEN(b.x)]) == gen, bar);
            __builtin_amdgcn_fence(__ATOMIC_ACQUIRE, "agent");
            asm volatile("s_waitcnt vmcnt(0)" ::: "memory");
        }
    }
    __syncthreads();
}

struct Args { const float* in[23]; float* out; unsigned char* ws; int ph_lo, ph_hi; };
struct Frame {
    LAS unsigned char* lds;
    int tid, lane, wave, vcu, G;
    const Args* a;
    unsigned char* ws;
};
#define WSP(T_, off) ((T_*)(F.ws + (off)))

__device__ __forceinline__ float wave_sum(float v) {
#pragma unroll
    for (int o = 1; o < 64; o <<= 1) v += __shfl_xor(v, o);
    return v;
}

__device__ __forceinline__ int destpos(int j, int ptype) {
    if (ptype == 1) return ((j >> 2) & 1) * 16 + ((j >> 3) << 2) + (j & 3);
    if (ptype == 2) return j < 8 ? j : (j < 16 ? j + 8 : (j < 24 ? j - 8 : j));
    return j;
}
__device__ __forceinline__ void tr_item(const float* W, int ldw, int k0, f16* WT, int ldt, int kdst0, int nrow0, int sbase, int valid, int ptype, LAS float* scr, int lane) {
    const int j4 = (lane & 7) * 4, dp = destpos(j4, ptype), kr = lane >> 3;
    f32x4 v[8];
#pragma unroll
    for (int i = 0; i < 8; ++i) v[i] = (j4 < valid) ? *(const f32x4*)(W + (size_t)(k0 + 8 * i + kr) * ldw + sbase + j4) : (f32x4){0.f, 0.f, 0.f, 0.f};
#pragma unroll
    for (int i = 0; i < 8; ++i) *(LAS f32x4*)(scr + (8 * i + kr) * 36 + (dp ^ (i << 2))) = v[i];
    LDS_WAIT(); asm volatile("" ::: "memory");
    const int c = lane & 7;
#pragma unroll
    for (int jj = 0; jj < 4; ++jj) { const int n = (lane >> 3) + 8 * jj; const LAS float* s = scr + (8 * c) * 36 + (n ^ (c << 2));
        u32x4 o; o.x = pk2h(s[0 * 36], s[1 * 36]); o.y = pk2h(s[2 * 36], s[3 * 36]); o.z = pk2h(s[4 * 36], s[5 * 36]); o.w = pk2h(s[6 * 36], s[7 * 36]);
        *(u32x4*)(WT + (size_t)(nrow0 + n) * ldt + kdst0 + k0 + 8 * c) = o; }
    LDS_WAIT(); asm volatile("" ::: "memory");
}
__device__ __forceinline__ void convert_ffn(Frame& F, const float* w_in, const float* w_out, f16* WINT, f16* WOUTT) {
    LAS float* scr = (LAS float*)(F.lds + F.wave * 16384);
    const int gw = F.vcu * 8 + F.wave, NGW = F.G * 8;
    constexpr int I_IN = (D / 64) * (2 * DFF / 32), I_OUT = (DFF / 64) * (D / 32);
    for (int it = gw; it < I_IN + I_OUT; it += NGW) {
        if (it < I_IN) {
            const int G = it % (2 * DFF / 32), kb = it / (2 * DFF / 32);
            const int pn = G >> 3, g8 = G & 7, bj = g8 >> 2, g = g8 & 3;
            tr_item(w_in, 2 * DFF, kb * 64, WINT, D, 0, G * 32, bj * DFF + pn * 128 + g * 32, 32, 1, scr, F.lane);
        } else {
            const int r = it - I_IN, G = r % (D / 32), kb = r / (D / 32);
            tr_item(w_out, D, kb * 64, WOUTT, DFF, 0, G * 32, G * 32, 32, 0, scr, F.lane);
        }
    }
}

__device__ __forceinline__ void p0_prologue(Frame& F) {
    const Args& A = *F.a;
    convert_ffn(F, A.in[2], A.in[3], WSP(f16, WS_W1IN), WSP(f16, WS_W1OUT));
    LAS float* scr = (LAS float*)(F.lds + F.wave * 16384);
    const int gw = F.vcu * 8 + F.wave, NGW = F.G * 8;
    {
        const float* W = A.in[6]; f16* WT = WSP(f16, WS_WIN);
        constexpr int NG = NINP / 32, I_W = (D / 64) * NG;
        for (int it = gw; it < I_W; it += NGW) {
            const int G = it % NG, kb = it / NG, tile = G >> 3;
            int sbase, valid = 32, ptype;
            if (tile < 10) { sbase = G * 32; ptype = 0; }
            else if (tile < 12) { sbase = G * 32; ptype = 1; }
            else if (tile < 48) { sbase = G * 32 + 1104; ptype = 1; }
            else if (tile < 52) { sbase = 3072 + (G * 32 - 12288); ptype = (G & 1) ? 0 : 2; }
            else { const int g8 = G - 416; if (g8 == 0) { sbase = 4096; ptype = 2; } else if (g8 == 1) { sbase = 4128; ptype = 0; } else if (g8 == 2) { sbase = 4160; valid = 16; ptype = 0; } else { sbase = 0; valid = 0; ptype = 0; } }
            tr_item(W, NIN, kb * 64, WT, D, 0, G * 32, sbase, valid, ptype, scr, F.lane);
        }
    }
    {
        f16* WC = WSP(f16, WS_WCAT); f16* WO = WSP(f16, WS_WOUT);
        constexpr int NG = D / 32, I_A = (D / 64) * NG, I_R = (DRNN / 64) * NG, I_O = (D / 64) * NG;
        for (int it = gw; it < I_A + I_R + I_O; it += NGW) {
            int r = it;
            if (r < I_A) { const int G = r % NG, kb = r / NG; tr_item(A.in[14], D, kb * 64, WC, KCAT, 0, G * 32, G * 32, 32, 1, scr, F.lane); continue; } r -= I_A;
            if (r < I_R) { const int G = r % NG, kb = r / NG; tr_item(A.in[15], D, kb * 64, WC, KCAT, 2048, G * 32, G * 32, 32, 1, scr, F.lane); continue; } r -= I_R;
            { const int G = r % NG, kb = r / NG; tr_item(A.in[16], D, kb * 64, WO, D, 0, G * 32, G * 32, 32, 0, scr, F.lane); }
        }
    }
    const int gt = F.vcu * 512 + F.tid, NGT = F.G * 512;
    {
        f16* WA = WSP(f16, WS_WAT); f16* WX = WSP(f16, WS_WXT);
        for (int i = gt; i < 2 * LRU_NB * LRU_BS * LRU_BS; i += NGT) {
            const int mat = i / (LRU_NB * LRU_BS * LRU_BS), r = i % (LRU_NB * LRU_BS * LRU_BS), n = r / (LRU_BS * LRU_BS), dc = r % (LRU_BS * LRU_BS), d = dc / LRU_BS, c = dc % LRU_BS;
            const float v = (mat ? A.in[11] : A.in[9])[(size_t)n * LRU_BS * LRU_BS + c * LRU_BS + d];
            (mat ? WX : WA)[r] = (f16)v;
        }
    }
    {
        const f32x4* x4 = (const f32x4*)A.in[0]; u32x2* xb = WSP(u32x2, WS_HB);
        for (int i = gt; i < T * D / 4; i += NGT) { const f32x4 v = x4[i]; u32x2 w; w.x = pk2h(v[0], v[1]); w.y = pk2h(v[2], v[3]); xb[i] = w; }
    }
    {
        const int* pos = (const int*)A.in[1];
        float* cq = (float*)(F.ws + WS_TAB + TAB_COSQ); float* sq = (float*)(F.ws + WS_TAB + TAB_SINQ);
        float* ci = (float*)(F.ws + WS_TAB + TAB_COSI); float* si = (float*)(F.ws + WS_TAB + TAB_SINI);
        for (int i = gt; i < T * 24; i += NGT) {
            const int tok = i / 24, j = i % 24;
            const float p = (float)pos[tok];
            if (j < 16) { const float inv = powf(500000.0f, -((float)j * 2.0f / 32.0f)); const float ang = p * inv; cq[tok * 16 + j] = cosf(ang); sq[tok * 16 + j] = sinf(ang); }
            else { const int jj = j - 16; const float inv = powf(500000.0f, -((float)jj * 2.0f / 16.0f)); const float ang = p * inv; ci[tok * 8 + jj] = cosf(ang); si[tok * 8 + jj] = sinf(ang); }
        }
        float* spl = (float*)(F.ws + WS_TAB + TAB_SPL);
        for (int i = gt; i < DRNN; i += NGT) { const float lam = A.in[13][i]; spl[i] = -8.0f * log1pf(expf(-lam)); }
    }
}

__device__ __forceinline__ void ln_phase(Frame& F, const float* R, const float* g, const float* b, f16* outh, float* outf) {
    const int gw = F.vcu * 8 + F.wave, NGW = F.G * 8;
    for (int row = gw; row < T; row += NGW) {
        const f32x4* xr = (const f32x4*)(R + (size_t)row * D) + F.lane;
        f32x4 v[8]; float s = 0.f;
#pragma unroll
        for (int j = 0; j < 8; ++j) { v[j] = xr[64 * j]; s += (v[j][0] + v[j][1]) + (v[j][2] + v[j][3]); }
        const float mean = wave_sum(s) * (1.f / D); float s2 = 0.f;
#pragma unroll
        for (int j = 0; j < 8; ++j) { v[j] = v[j] - mean; s2 += (v[j][0] * v[j][0] + v[j][1] * v[j][1]) + (v[j][2] * v[j][2] + v[j][3] * v[j][3]); }
        const float rstd = 1.0f / sqrtf(wave_sum(s2) * (1.f / D) + LN_EPS);
#pragma unroll
        for (int j = 0; j < 8; ++j) {
            const f32x4 gg = ((const f32x4*)g)[64 * j + F.lane], bb = ((const f32x4*)b)[64 * j + F.lane];
            const f32x4 o = v[j] * rstd * gg + bb;
            if (outf) ((f32x4*)(outf + (size_t)row * D))[64 * j + F.lane] = o;
            else { u32x2 w; w.x = pk2h(o[0], o[1]); w.y = pk2h(o[2], o[3]); ((u32x2*)(outh + (size_t)row * D))[64 * j + F.lane] = w; }
        }
    }
}

constexpr int SROW = 2052;
__device__ __forceinline__ unsigned f2key(float f) { const unsigned u = __builtin_bit_cast(unsigned, f); return (u & 0x80000000u) ? ~u : (u | 0x80000000u); }
__device__ __forceinline__ void indexer_item(Frame& F, int b, int qb) {
    const f16* QI = WSP(f16, WS_QI); const f16* KI = WSP(f16, WS_KI); const float* WI = WSP(float, WS_WI); u64* MASK = WSP(u64, WS_MASK);
    LAS float* S = (LAS float*)F.lds;
    const int lane = F.lane, wave = F.wave, c16 = lane & 15, g4 = lane >> 4;
    const int q0 = qb * 16, tok = b * SEQ + q0 + c16;
    f16x8 qf[16][2];
#pragma unroll
    for (int h = 0; h < 16; ++h)
#pragma unroll
        for (int ks = 0; ks < 2; ++ks) qf[h][ks] = *(const f16x8*)(QI + (size_t)tok * 1024 + h * 64 + ks * 32 + g4 * 8);
    float wq[16];
#pragma unroll
    for (int h4 = 0; h4 < 4; ++h4) { const f32x4 w = *(const f32x4*)(WI + (size_t)tok * 16 + h4 * 4); wq[h4 * 4 + 0] = w[0]; wq[h4 * 4 + 1] = w[1]; wq[h4 * 4 + 2] = w[2]; wq[h4 * 4 + 3] = w[3]; }
    const int nkt = qb + 1;
    f16x8 k0n = {}, k1n = {};
    if (wave < nkt) { const f16* kp = KI + (size_t)(b * SEQ + wave * 16 + c16) * 64 + g4 * 8; k0n = *(const f16x8*)kp; k1n = *(const f16x8*)(kp + 32); }
    for (int kt = wave; kt < nkt; kt += 8) {
        const f16x8 k0 = k0n, k1 = k1n;
        if (kt + 8 < nkt) { const f16* kp = KI + (size_t)(b * SEQ + (kt + 8) * 16 + c16) * 64 + g4 * 8; k0n = *(const f16x8*)kp; k1n = *(const f16x8*)(kp + 32); }
        f32x4 sc = {0.f, 0.f, 0.f, 0.f};
#pragma unroll
        for (int h = 0; h < 16; ++h) {
            f32x4 z = {0.f, 0.f, 0.f, 0.f};
            z = __builtin_amdgcn_mfma_f32_16x16x32_f16(k0, qf[h][0], z, 0, 0, 0);
            z = __builtin_amdgcn_mfma_f32_16x16x32_f16(k1, qf[h][1], z, 0, 0, 0);
#pragma unroll
            for (int e = 0; e < 4; ++e) sc[e] += wq[h] * fmaxf(z[e], 0.f);
        }
        *(LAS f32x4*)(S + c16 * SROW + kt * 16 + g4 * 4) = sc;
    }
    __syncthreads();
    for (int rr = wave; rr < 16; rr += 8) {
        const int t = q0 + rr;
        const LAS float* row = S + rr * SROW;
        u64* mrow = MASK + (size_t)(b * SEQ + t) * 32;
        if (t < TOPK) {
            for (int i = 0; i < 32; ++i) { const u64 m = __ballot(64 * i + lane <= t); if (lane == 0) mrow[i] = m; }
        } else {
            unsigned key[32];
#pragma unroll
            for (int i = 0; i < 32; ++i) { const int k = 64 * i + lane; key[i] = (k <= t) ? f2key(row[k]) : 0u; }
            unsigned thr = 0u;
            for (int bit = 31; bit >= 0; --bit) {
                const unsigned cand = thr | (1u << bit);
                int cnt = 0;
#pragma unroll
                for (int i = 0; i < 32; ++i) cnt += __popcll(__ballot(key[i] >= cand));
                if (cnt >= TOPK) thr = cand;
            }
            int cgt = 0;
#pragma unroll
            for (int i = 0; i < 32; ++i) cgt += __popcll(__ballot(key[i] > thr));
            int need = TOPK - cgt;
#pragma unroll
            for (int i = 0; i < 32; ++i) {
                const u64 eq = __ballot(key[i] == thr);
                const int before = __popcll(eq & ((1ull << lane) - 1ull));
                const bool sel = (key[i] > thr) || (key[i] == thr && before < need);
                need -= __popcll(eq);
                const u64 m = __ballot(sel);
                if (lane == 0) mrow[i] = m;
            }
        }
    }
    __syncthreads();
}
__device__ __forceinline__ void p5_phase(Frame& F, f16* YOUT, int ldy, unsigned* qhead);
constexpr int TS = 32, XROW = 168, HROW = 84;
constexpr int RS_X16 = 0, RS_H = 2 * TS * XROW * 2;
__device__ __forceinline__ float neg_expm1_small(float x) {
    float p = 1.0f / 5040.0f; p = p * x + 1.0f / 720.0f; p = p * x + 1.0f / 120.0f; p = p * x + 1.0f / 24.0f; p = p * x + 1.0f / 6.0f; p = p * x + 0.5f; p = p * x + 1.0f;
    return -x * p;
}
__device__ __forceinline__ void rnn_seq(Frame& F, int b, int n, int hf, f16* YOUT, int ldy) {
    const Args& A = *F.a;
    const f16* RX = WSP(f16, WS_RX); const f16* YC = WSP(f16, WS_YCAT);
    LAS f16* X16 = (LAS f16*)(F.lds + RS_X16); LAS float* HB = (LAS float*)(F.lds + RS_H);
    const int tid = F.tid, lane = F.lane, wave = F.wave, c16 = lane & 15, g4 = lane >> 4;
    const int ch0 = n * LRU_BS;
    if (wave < 5) {
        const int chl = 16 * wave + c16, cloc = 80 * hf + chl, cg = ch0 + cloc;
        const f16* wap = WSP(f16, WS_WAT) + (size_t)n * LRU_BS * LRU_BS + (size_t)cloc * LRU_BS + g4 * 8;
        const f16* wxp = WSP(f16, WS_WXT) + (size_t)n * LRU_BS * LRU_BS + (size_t)cloc * LRU_BS + g4 * 8;
        f16x8 wa[5], wx[5];
#pragma unroll
        for (int ks = 0; ks < 5; ++ks) { wa[ks] = *(const f16x8*)(wap + ks * 32); wx[ks] = *(const f16x8*)(wxp + ks * 32); }
        const float bav = A.in[10][cg], bxv = A.in[12][cg], sp = ((const float*)(F.ws + WS_TAB + TAB_SPL))[cg];
        float H = 0.f;
        asm volatile("s_waitcnt lgkmcnt(0)" ::: "memory"); __builtin_amdgcn_s_barrier();
        for (int i = 0; i < SEQ / TS; ++i) {
            const LAS f16* xb = X16 + (i & 1) * TS * XROW; LAS float* hb = HB + (i & 1) * TS * HROW;
            float av[2][4], bv[2][4], Pm[2], Qm[2];
#pragma unroll
            for (int tt = 0; tt < 2; ++tt) {
                f32x4 zr = {0.f, 0.f, 0.f, 0.f}, zi = {0.f, 0.f, 0.f, 0.f};
#pragma unroll
                for (int ks = 0; ks < 5; ++ks) {
                    const f16x8 xa = *(const LAS f16x8*)(xb + (tt * 16 + c16) * XROW + ks * 32 + g4 * 8);
                    zr = __builtin_amdgcn_mfma_f32_16x16x32_f16(xa, wa[ks], zr, 0, 0, 0);
                    zi = __builtin_amdgcn_mfma_f32_16x16x32_f16(xa, wx[ks], zi, 0, 0, 0);
                }
#pragma unroll
                for (int e = 0; e < 4; ++e) {
                    const float xc = (float)xb[(tt * 16 + 4 * g4 + e) * XROW + cloc];
                    const float r = sigmoidf_(zr[e] + bav), ig = sigmoidf_(zi[e] + bxv);
                    const float log_a = sp * r;
                    av[tt][e] = fast_exp2(1.4426950408889634f * log_a);
                    bv[tt][e] = __builtin_amdgcn_sqrtf(neg_expm1_small(2.0f * log_a)) * (ig * xc);
                }
                float P = av[tt][0], Q = bv[tt][0];
#pragma unroll
                for (int e = 1; e < 4; ++e) { P *= av[tt][e]; Q = av[tt][e] * Q + bv[tt][e]; }
                Pm[tt] = P; Qm[tt] = Q;
            }
            float cin0 = 0.f, cin1 = 0.f, c = H;
#pragma unroll
            for (int j = 0; j < 8; ++j) {
                const int tt = j >> 2, g = j & 3;
                const float Pj = __shfl(Pm[tt], c16 + 16 * g), Qj = __shfl(Qm[tt], c16 + 16 * g);
                if (tt == 0) cin0 = (g == g4) ? c : cin0; else cin1 = (g == g4) ? c : cin1;
                c = Pj * c + Qj;
            }
            H = c;
#pragma unroll
            for (int tt = 0; tt < 2; ++tt) {
                float h = tt == 0 ? cin0 : cin1;
#pragma unroll
                for (int e = 0; e < 4; ++e) { h = av[tt][e] * h + bv[tt][e]; hb[(tt * 16 + 4 * g4 + e) * HROW + chl] = h; }
            }
            asm volatile("s_waitcnt lgkmcnt(0)" ::: "memory"); __builtin_amdgcn_s_barrier();
        }
    } else {
        const int p = tid - 320;
        const bool xact = p < 160;
        const int cgx = p % 20, run = p / 20, cx = ch0 + cgx * 8;
        float cw[4][8], cb[8];
#pragma unroll
        for (int j = 0; j < 4; ++j)
#pragma unroll
            for (int e = 0; e < 8; ++e) cw[j][e] = xact ? A.in[7][j * DRNN + cx + e] : 0.f;
#pragma unroll
        for (int e = 0; e < 8; ++e) cb[e] = xact ? A.in[8][cx + e] : 0.f;
        u32x4 rows[7];
        auto load_rows = [&](int s0) {
#pragma unroll
            for (int r = 0; r < 7; ++r) { const int ss = s0 + 4 * run - 3 + r; rows[r] = (xact && ss >= 0) ? *(const u32x4*)(RX + (size_t)(b * SEQ + ss) * DRNN + cx) : (u32x4){0u, 0u, 0u, 0u}; }
        };
        auto conv_write = [&](int buf) {
            if (xact) {
                LAS f16* xb = X16 + buf * TS * XROW;
#pragma unroll
                for (int t4 = 0; t4 < 4; ++t4) {
                    float xc[8];
#pragma unroll
                    for (int e = 0; e < 8; ++e) xc[e] = cb[e];
#pragma unroll
                    for (int j = 0; j < 4; ++j) { const f16x8 xv = __builtin_bit_cast(f16x8, rows[t4 + j]);
#pragma unroll
                        for (int e = 0; e < 8; ++e) xc[e] += (float)xv[e] * cw[j][e]; }
                    u32x4 w; w.x = pk2h(xc[0], xc[1]); w.y = pk2h(xc[2], xc[3]); w.z = pk2h(xc[4], xc[5]); w.w = pk2h(xc[6], xc[7]);
                    *(LAS u32x4*)(xb + (4 * run + t4) * XROW + cgx * 8) = w;
                }
            }
        };
        u32x4 grg[2];
        auto load_grg = [&](int s0) {
#pragma unroll
            for (int r = 0; r < 2; ++r) { const int u = p + 192 * r; if (u < 320) { const int tk = u / 10, cgy = u % 10; grg[r] = *(const u32x4*)(YC + (size_t)(b * SEQ + s0 + tk) * KCAT + 2048 + ch0 + 80 * hf + cgy * 8); } }
        };
        auto y_write = [&](int s0, int buf) {
            const LAS float* hb = HB + buf * TS * HROW;
#pragma unroll
            for (int r = 0; r < 2; ++r) { const int u = p + 192 * r; if (u < 320) { const int tk = u / 10, cgy = u % 10;
                const f32x4 h0 = *(const LAS f32x4*)(hb + tk * HROW + cgy * 8), h1 = *(const LAS f32x4*)(hb + tk * HROW + cgy * 8 + 4);
                const f16x8 gv = __builtin_bit_cast(f16x8, grg[r]);
                u32x4 w; w.x = pk2h(h0[0] * (float)gv[0], h0[1] * (float)gv[1]); w.y = pk2h(h0[2] * (float)gv[2], h0[3] * (float)gv[3]);
                w.z = pk2h(h1[0] * (float)gv[4], h1[1] * (float)gv[5]); w.w = pk2h(h1[2] * (float)gv[6], h1[3] * (float)gv[7]);
                *(u32x4*)(YOUT + (size_t)(b * SEQ + s0 + tk) * ldy + ch0 + 80 * hf + cgy * 8) = w; } }
        };
        load_rows(0); conv_write(0); load_rows(TS);
        asm volatile("s_waitcnt lgkmcnt(0)" ::: "memory"); __builtin_amdgcn_s_barrier();
        for (int i = 0; i < SEQ / TS; ++i) {
            if (i + 1 < SEQ / TS) { conv_write((i + 1) & 1); if (i + 2 < SEQ / TS) load_rows((i + 2) * TS); }
            if (i >= 1) y_write((i - 1) * TS, (i - 1) & 1);
            load_grg(i * TS);
            asm volatile("s_waitcnt lgkmcnt(0)" ::: "memory"); __builtin_amdgcn_s_barrier();
        }
        y_write((SEQ / TS - 1) * TS, (SEQ / TS - 1) & 1);
    }
    __syncthreads();
}

__device__ __forceinline__ void p5_phase(Frame& F, f16* YOUT, int ldy, unsigned* qhead) {
    if (F.vcu < 128) rnn_seq(F, F.vcu >> 5, (F.vcu >> 1) & 15, F.vcu & 1, YOUT, ldy);
    volatile LAS unsigned* slot = (volatile LAS unsigned*)(F.lds + LDSCTL_OFF + 64);
    for (;;) {
        if (F.tid == 0) slot[0] = __hip_atomic_fetch_add(qhead, 1u, __ATOMIC_RELAXED, __HIP_MEMORY_SCOPE_AGENT);
        __syncthreads();
        const unsigned it = slot[0];
        __syncthreads();
        if (it >= 512u) break;
        indexer_item(F, (int)(it & 3u), 127 - (int)(it >> 2));
    }
}
constexpr int KROW = 272, VROW = 320;
constexpr int AT_K = 0, AT_V = 64 * KROW;
__device__ __forceinline__ void attn_item(Frame& F, int b, int g, int qb, f16* YOUT, int ldy) {
    const f16* YC = WSP(f16, WS_YCAT); const f16* KB = WSP(f16, WS_K); const f16* VB = WSP(f16, WS_V); const u64* MASK = WSP(u64, WS_MASK);
    LAS unsigned char* lds = F.lds;
    const int tid = F.tid, lane = F.lane, wave = F.wave, r32 = lane & 31, hi = lane >> 5;
    const int head = g * 4 + (wave >> 1), q0 = qb * 64 + (wave & 1) * 32, tokq = b * SEQ + q0 + r32;
    f16x8 qf[8];
#pragma unroll
    for (int ks = 0; ks < 8; ++ks) qf[ks] = *(const f16x8*)(YC + (size_t)tokq * KCAT + head * 128 + ks * 16 + hi * 8);
    f32x16 o[4];
#pragma unroll
    for (int d = 0; d < 4; ++d) o[d] = (f32x16){};
    float mrun = -1e30f, lrun = 0.f;
    const int ntile = qb + 1;
    u32x4 kreg[2], vreg[2];
    auto gload = [&](int kt) {
#pragma unroll
        for (int i = 0; i < 2; ++i) { const int piece = tid + 512 * i, key = piece >> 4, ch = piece & 15; const size_t off = (size_t)(b * SEQ + kt * 64 + key) * 512 + g * 128 + ch * 8;
            kreg[i] = *(const u32x4*)(KB + off); vreg[i] = *(const u32x4*)(VB + off); }
    };
    auto swrite = [&]() {
#pragma unroll
        for (int i = 0; i < 2; ++i) { const int piece = tid + 512 * i, key = piece >> 4, ch = piece & 15;
            *(LAS u32x4*)(lds + AT_K + key * KROW + ch * 16) = kreg[i]; *(LAS u32x4*)(lds + AT_V + key * VROW + ch * 16) = vreg[i]; }
    };
    gload(0);
    for (int kt = 0; kt < ntile; ++kt) {
        __syncthreads();
        swrite();
        __syncthreads();
        if (kt + 1 < ntile) gload(kt + 1);
        const u64 mword = MASK[(size_t)tokq * 32 + kt];
        f32x16 p[2];
#pragma unroll
        for (int kb = 0; kb < 2; ++kb) {
            f32x16 acc = (f32x16){};
#pragma unroll
            for (int ks = 0; ks < 8; ++ks) {
                const f16x8 kf = *(const LAS f16x8*)(lds + AT_K + (kb * 32 + r32) * KROW + ks * 32 + hi * 16);
                acc = __builtin_amdgcn_mfma_f32_32x32x16_f16(kf, qf[ks], acc, 0, 0, 0);
            }
            p[kb] = acc;
        }
        float mx = -1e30f;
#pragma unroll
        for (int kb = 0; kb < 2; ++kb)
#pragma unroll
            for (int r = 0; r < 16; ++r) { const int kk = kb * 32 + (r & 3) + 8 * (r >> 2) + 4 * hi; const bool ok = (mword >> kk) & 1ull; p[kb][r] = ok ? p[kb][r] : -1e30f; mx = fmaxf(mx, p[kb][r]); }
        mx = fmaxf(mx, __shfl_xor(mx, 32));
        const float mnew = fmaxf(mrun, mx), alpha = fast_exp2(mrun - mnew);
        float ls = 0.f;
#pragma unroll
        for (int kb = 0; kb < 2; ++kb)
#pragma unroll
            for (int r = 0; r < 16; ++r) { const float e = (p[kb][r] > -1e29f) ? fast_exp2(p[kb][r] - mnew) : 0.f; p[kb][r] = e; ls += e; }
        ls += __shfl_xor(ls, 32);
        lrun = lrun * alpha + ls; mrun = mnew;
#pragma unroll
        for (int d = 0; d < 4; ++d)
#pragma unroll
            for (int r = 0; r < 16; ++r) o[d][r] *= alpha;
        f16x8 pf[4];
#pragma unroll
        for (int kb = 0; kb < 2; ++kb)
#pragma unroll
            for (int s = 0; s < 2; ++s) {
                u32x4 w; w.x = pk2h(p[kb][8 * s + 0], p[kb][8 * s + 1]); w.y = pk2h(p[kb][8 * s + 2], p[kb][8 * s + 3]); w.z = pk2h(p[kb][8 * s + 4], p[kb][8 * s + 5]); w.w = pk2h(p[kb][8 * s + 6], p[kb][8 * s + 7]);
                pf[kb * 2 + s] = __builtin_bit_cast(f16x8, w);
            }
        const int li = lane & 15, dgrp = (lane >> 4) & 1;
#pragma unroll
        for (int db = 0; db < 4; ++db) {
#pragma unroll
            for (int st = 0; st < 4; ++st) {
                const int key0 = 16 * st + 4 * hi;
                const LAS unsigned char* vp = lds + AT_V + (key0 + (li >> 2)) * VROW + (db * 32 + dgrp * 16 + 4 * (li & 3)) * 2;
                const s16x4 lo = __builtin_amdgcn_ds_read_tr16_b64_v4i16((LAS s16x4*)vp);
                const s16x4 hi4 = __builtin_amdgcn_ds_read_tr16_b64_v4i16((LAS s16x4*)(vp + 8 * VROW));
                typedef short s16x8 __attribute__((ext_vector_type(8)));
                const s16x8 vv = {lo[0], lo[1], lo[2], lo[3], hi4[0], hi4[1], hi4[2], hi4[3]};
                o[db] = __builtin_amdgcn_mfma_f32_32x32x16_f16(__builtin_bit_cast(f16x8, vv), pf[st], o[db], 0, 0, 0);
            }
        }
    }
    const float inv = fast_rcp(lrun);
#pragma unroll
    for (int db = 0; db < 4; ++db)
#pragma unroll
        for (int r4 = 0; r4 < 4; ++r4) {
            u32x2 w; w.x = pk2h(o[db][4 * r4 + 0] * inv, o[db][4 * r4 + 1] * inv); w.y = pk2h(o[db][4 * r4 + 2] * inv, o[db][4 * r4 + 3] * inv);
            *(u32x2*)(YOUT + (size_t)tokq * ldy + head * 128 + db * 32 + 8 * r4 + 4 * hi) = w;
        }
    __syncthreads();
}
__device__ __forceinline__ void attn_phase(Frame& F, f16* YOUT, int ldy) {
    for (int rep = 0; rep < 2; ++rep)
        for (int vv = F.vcu; vv < 256; vv += F.G) {
            const int b = vv >> 6, w = vv & 63, g = w >> 4, j = w & 15;
            attn_item(F, b, g, rep == 0 ? j : 31 - j, YOUT, ldy);
        }
}

__global__ void __launch_bounds__(512, 2) mk_fwd(Args args) {
    extern __shared__ __attribute__((aligned(16))) unsigned char lds_raw[];
    Frame F;
    F.lds = (LAS unsigned char*)lds_raw;
    F.tid = threadIdx.x; F.lane = F.tid & 63; F.wave = __builtin_amdgcn_readfirstlane(F.tid >> 6);
    F.G = gridDim.x; { const int bx = blockIdx.x; F.vcu = (F.G % 8 == 0) ? (bx % 8) * (F.G / 8) + bx / 8 : bx; }
    F.a = &args; F.ws = args.ws;
    const int lo = args.ph_lo, hi = args.ph_hi;
    volatile LAS unsigned* MISC = (volatile LAS unsigned*)(F.lds + LDSCTL_OFF);
    if (F.tid < 32) MISC[F.tid] = 0u;
    __syncthreads();
    XcdBarrier bar; bar.bar = (unsigned*)(F.ws + WS_CTL) + 4096; bar.x = 0; bar.st = nullptr;
    if (hi - lo > 1) bar = xcd_barrier_post((unsigned*)(F.ws + WS_CTL) + 4096, MISC + 8);
#define IN(k) (lo <= (k) && (k) < hi)
#define SEAM(k) do { if (IN(k) && IN((k) + 1)) xcd_barrier(bar); } while (0)
#define PROBE_PH -1
#ifndef PROBE_REPS
#define PROBE_REPS 2
#endif
#define REPS(k) for (int prep = (PROBE_PH == (k) ? PROBE_REPS : 0); prep >= 0; --prep)
#define RSEAM(k) do { if (prep > 0) xcd_barrier(bar); } while (0)
    const Args& A = args;
    pg8::StaticOrder S;
    if (IN(0)) REPS(0) { p0_prologue(F); RSEAM(0); } SEAM(0);
    if (IN(1)) REPS(1) {
        pg8::Gemm g{WSP(f16, WS_HB), WSP(f16, WS_W1IN), T, 2 * DFF, D}; S.init(T, 2 * DFF, F.G, (int)blockIdx.x);
        EpiSwiglu E{WSP(f16, WS_ACT)};
        pg8::gemm_phase<EpiSwiglu, 0>(F.lds, g, S, E);
        RSEAM(1);
    } SEAM(1);
    if (IN(2)) REPS(2) {
        pg8::Gemm g{WSP(f16, WS_ACT), WSP(f16, WS_W1OUT), T, D, DFF}; S.init(T, D, F.G, (int)blockIdx.x);
        EpiResid<true> E{(const void*)A.in[0], WSP(float, WS_R), DN_ALPHA, 0.5f};
        pg8::gemm_phase<EpiResid<true>, 0>(F.lds, g, S, E);
        RSEAM(2);
    } SEAM(2);
    if (IN(3)) REPS(3) { ln_phase(F, WSP(float, WS_R), A.in[4], A.in[5], WSP(f16, WS_HB), nullptr); RSEAM(3); } SEAM(3);
    if (IN(4)) {
        if (PROBE_PH == 4) { {
        pg8::Gemm g{WSP(f16, WS_HB), WSP(f16, WS_WIN), T, NINP, D}; S.init(T, NINP, F.G, (int)blockIdx.x);
        EpiMixer E{WSP(f16, WS_YCAT), WSP(f16, WS_K), WSP(f16, WS_V), WSP(f16, WS_RX), WSP(f16, WS_GATES), WSP(f16, WS_QI), WSP(f16, WS_KI), WSP(float, WS_WI),
                   (const float*)(F.ws + WS_TAB + TAB_COSQ), (const float*)(F.ws + WS_TAB + TAB_SINQ), (const float*)(F.ws + WS_TAB + TAB_COSI), (const float*)(F.ws + WS_TAB + TAB_SINI)};
        pg8::gemm_phase<EpiMixer, 0>(F.lds, g, S, E);
        } xcd_barrier(bar); {
        pg8::Gemm g{WSP(f16, WS_HB), WSP(f16, WS_WIN), T, NINP, D}; S.init(T, NINP, F.G, (int)blockIdx.x);
        EpiMixer E{WSP(f16, WS_YCAT), WSP(f16, WS_K), WSP(f16, WS_V), WSP(f16, WS_RX), WSP(f16, WS_GATES), WSP(f16, WS_QI), WSP(f16, WS_KI), WSP(float, WS_WI),
                   (const float*)(F.ws + WS_TAB + TAB_COSQ), (const float*)(F.ws + WS_TAB + TAB_SINQ), (const float*)(F.ws + WS_TAB + TAB_COSI), (const float*)(F.ws + WS_TAB + TAB_SINI)};
        pg8::gemm_phase<EpiMixer, 0>(F.lds, g, S, E);
        } xcd_barrier(bar); }
        {
        pg8::Gemm g{WSP(f16, WS_HB), WSP(f16, WS_WIN), T, NINP, D}; S.init(T, NINP, F.G, (int)blockIdx.x);
        EpiMixer E{WSP(f16, WS_YCAT), WSP(f16, WS_K), WSP(f16, WS_V), WSP(f16, WS_RX), WSP(f16, WS_GATES), WSP(f16, WS_QI), WSP(f16, WS_KI), WSP(float, WS_WI),
                   (const float*)(F.ws + WS_TAB + TAB_COSQ), (const float*)(F.ws + WS_TAB + TAB_SINQ), (const float*)(F.ws + WS_TAB + TAB_COSI), (const float*)(F.ws + WS_TAB + TAB_SINI)};
        pg8::gemm_phase<EpiMixer, 0>(F.lds, g, S, E);
        }
    } SEAM(4);
    if (IN(5)) {
        unsigned* qh = (unsigned*)(F.ws + WS_CTL) + 8192;
        if (PROBE_PH == 5) { p5_phase(F, WSP(f16, WS_MERGED), DRNN, qh); xcd_barrier(bar); p5_phase(F, WSP(f16, WS_MERGED), DRNN, qh + 64); xcd_barrier(bar); p5_phase(F, WSP(f16, WS_YCAT) + 2048, KCAT, qh + 128); }
        else p5_phase(F, WSP(f16, WS_YCAT) + 2048, KCAT, qh);
    } SEAM(5);
    if (IN(6)) REPS(6) { attn_phase(F, prep > 0 ? WSP(f16, WS_MERGED) : WSP(f16, WS_YCAT), prep > 0 ? D : KCAT); RSEAM(6); } SEAM(6);
    if (IN(7)) {
        if (PROBE_PH == 7) { {
        pg8::Gemm g{WSP(f16, WS_YCAT), WSP(f16, WS_WCAT), T, D, KCAT}; S.init(T, D, F.G, (int)blockIdx.x);
        EpiMerged E{WSP(f16, WS_GATES), WSP(f16, WS_MERGED)};
        pg8::gemm_phase<EpiMerged, 32>(F.lds, g, S, E);
        } xcd_barrier(bar); {
        pg8::Gemm g{WSP(f16, WS_YCAT), WSP(f16, WS_WCAT), T, D, KCAT}; S.init(T, D, F.G, (int)blockIdx.x);
        EpiMerged E{WSP(f16, WS_GATES), WSP(f16, WS_MERGED)};
        pg8::gemm_phase<EpiMerged, 32>(F.lds, g, S, E);
        } xcd_barrier(bar); }
        {
        pg8::Gemm g{WSP(f16, WS_YCAT), WSP(f16, WS_WCAT), T, D, KCAT}; S.init(T, D, F.G, (int)blockIdx.x);
        EpiMerged E{WSP(f16, WS_GATES), WSP(f16, WS_MERGED)};
        pg8::gemm_phase<EpiMerged, 32>(F.lds, g, S, E);
        }
    } SEAM(7);
    if (IN(8)) REPS(8) {
        pg8::Gemm g{WSP(f16, WS_MERGED), WSP(f16, WS_WOUT), T, D, D}; S.init(T, D, F.G, (int)blockIdx.x);
        EpiResid<false> E{(const void*)WSP(f16, WS_HB), WSP(float, WS_R), DN_ALPHA, 1.0f};
        pg8::gemm_phase<EpiResid<false>, 0>(F.lds, g, S, E);
        RSEAM(8);
    } SEAM(8);
    if (IN(9)) REPS(9) { ln_phase(F, WSP(float, WS_R), A.in[17], A.in[18], WSP(f16, WS_HB), nullptr); convert_ffn(F, A.in[19], A.in[20], WSP(f16, WS_W1IN), WSP(f16, WS_W1OUT)); RSEAM(9); } SEAM(9);
    if (IN(10)) REPS(10) {
        pg8::Gemm g{WSP(f16, WS_HB), WSP(f16, WS_W1IN), T, 2 * DFF, D}; S.init(T, 2 * DFF, F.G, (int)blockIdx.x);
        EpiSwiglu E{WSP(f16, WS_ACT)};
        pg8::gemm_phase<EpiSwiglu, 0>(F.lds, g, S, E);
        RSEAM(10);
    } SEAM(10);
    if (IN(11)) REPS(11) {
        pg8::Gemm g{WSP(f16, WS_ACT), WSP(f16, WS_W1OUT), T, D, DFF}; S.init(T, D, F.G, (int)blockIdx.x);
        EpiResid<false> E{(const void*)WSP(f16, WS_HB), WSP(float, WS_R), DN_ALPHA, 0.5f};
        pg8::gemm_phase<EpiResid<false>, 0>(F.lds, g, S, E);
        RSEAM(11);
    } SEAM(11);
    if (IN(12)) REPS(12) { ln_phase(F, WSP(float, WS_R), A.in[21], A.in[22], nullptr, args.out); RSEAM(12); }
#undef IN
#undef SEAM
}

extern "C" void kernel_launch(void* const* d_in, const int* in_sizes, int n_in, void* d_out, int out_size, void* d_ws, size_t ws_size, hipStream_t stream) {
    static int grid = 0;
    if (grid == 0) {
        if (n_in != 23 || in_sizes[0] != T * D || out_size != T * D || ws_size < WS_END) { fprintf(stderr, "kernel_launch: unexpected shapes (n_in %d, in0 %d, out %d, ws %zu)\n", n_in, n_in > 0 ? in_sizes[0] : -1, out_size, ws_size); grid = -1; return; }
        int dev = 0, cus = 0, per_cu = 0;
        if (hipGetDevice(&dev) != hipSuccess || hipDeviceGetAttribute(&cus, hipDeviceAttributeMultiprocessorCount, dev) != hipSuccess) { grid = -1; return; }
        if (hipFuncSetAttribute((const void*)mk_fwd, hipFuncAttributeMaxDynamicSharedMemorySize, LDS_BYTES) != hipSuccess) { fprintf(stderr, "kernel_launch: hipFuncSetAttribute failed\n"); grid = -1; return; }
        if (hipOccupancyMaxActiveBlocksPerMultiprocessor(&per_cu, (const void*)mk_fwd, 512, LDS_BYTES) != hipSuccess || per_cu < 1) { fprintf(stderr, "kernel_launch: occupancy query reports %d\n", per_cu); per_cu = 1; }
        (void)hipGetLastError();
        grid = cus * 1;
        if (grid > 256) grid = 256;
    }
    if (grid < 0) return;
    (void)hipMemsetAsync((char*)d_ws + WS_CTL, 0, CTL_BYTES, stream);
    Args a{};
    for (int i = 0; i < 23; ++i) a.in[i] = (const float*)d_in[i];
    a.out = (float*)d_out; a.ws = (unsigned char*)d_ws;
    if (MK_LAUNCHES == 1) {
        a.ph_lo = 0; a.ph_hi = NPHASE;
        hipLaunchKernelGGL(mk_fwd, dim3(grid), dim3(512), LDS_BYTES, stream, a);
    } else {
        for (int p = 0; p < NPHASE; ++p) { a.ph_lo = p; a.ph_hi = p + 1; hipLaunchKernelGGL(mk_fwd, dim3(grid), dim3(512), LDS_BYTES, stream, a); }
    }
}
```
